# Optimizing an MI355X kernel written in HIP

```python
import math
import jax, jax.numpy as jnp
from jax import lax
import numpy as np

D_MODEL = 1024
BATCH = 16
SEQ = 2048
DEPTH = 1

CHUNK = 64
D_MIX = D_MODEL
A_HEADS = 8
A_HEAD_DIM = 64
A_WIDTH = A_HEADS * A_HEAD_DIM
IDX_HEADS = 8
IDX_DIM = 32
TOPK_MAX = 256
B_HEADS = 4
B_KEY_DIM = 64
B_VAL_DIM = 128
B_WIDTH = B_HEADS * B_VAL_DIM
B_KEY_WIDTH = B_HEADS * B_KEY_DIM
GATE_RANK = 16
GATE_NORMALIZER = 16.0
N_BUCKETS = 32
MAX_DISTANCE = 128
D_FF = ((8 * D_MODEL + 3 * 256 - 1) // (3 * 256)) * 256
EPS = 1e-6
NEG = -1e30

SPLIT_SIZES = (
    A_WIDTH, A_WIDTH, A_WIDTH,
    IDX_HEADS * IDX_DIM, IDX_DIM, IDX_HEADS,
    B_KEY_WIDTH, B_KEY_WIDTH, B_WIDTH,
    GATE_RANK, B_WIDTH,
)
D_IN = sum(SPLIT_SIZES)

kernel_name = "hymba_dsa_gla_streaming_block"


def rmsnorm(x, g):
    xf = x.astype(jnp.float32)
    y = xf * lax.rsqrt(jnp.mean(xf * xf, axis=-1, keepdims=True) + EPS)
    return (y * g.astype(jnp.float32)).astype(x.dtype)


def t5_bucket(rel):
    half = N_BUCKETS // 2
    max_exact = half // 2
    ret = jnp.where(rel > 0, half, 0)
    n = jnp.abs(rel)
    nf = jnp.maximum(n, 1).astype(jnp.float32)
    large = max_exact + (jnp.log(nf / max_exact) / math.log(MAX_DISTANCE / max_exact)
                         * (half - max_exact)).astype(jnp.int32)
    large = jnp.minimum(large, half - 1)
    return ret + jnp.where(n < max_exact, n, large)


def dsa_mixer(q, k, v, q_idx, k_idx, w_idx, rel_bias):
    bsz, seq = q.shape[0], q.shape[1]
    topk = min(TOPK_MAX, seq // 4)
    n_blk = seq // CHUNK
    key_pos = jnp.arange(seq)
    k_idx_f = k_idx.astype(jnp.float32)

    def block(args):
        n, qb, qib, wb = args
        limit = (n + 1) * CHUNK
        qpos = n * CHUNK + jnp.arange(CHUNK)
        dots = jax.nn.relu(jnp.einsum('bqhd,bsd->bqhs', qib.astype(jnp.float32), k_idx_f)
                           * IDX_DIM ** -0.5)
        score = jnp.einsum('bqhs,bqh->bqs', dots, wb.astype(jnp.float32) * IDX_HEADS ** -0.5)
        score = jnp.where(key_pos[None, None, :] < limit, score, NEG)
        _, sel = lax.top_k(score, topk)
        valid = sel < limit
        kg = jax.vmap(lambda kb, ib: kb[ib])(k, sel)
        vg = jax.vmap(lambda vb, ib: vb[ib])(v, sel)
        bias = rel_bias[t5_bucket(sel - qpos[None, :, None])]
        logits = (jnp.einsum('bqhd,bqkhd->bqhk', qb, kg).astype(jnp.float32) * A_HEAD_DIM ** -0.5
                  + jnp.swapaxes(bias, 2, 3).astype(jnp.float32))
        logits = jnp.where(valid[:, :, None, :], logits, NEG)
        p = jax.nn.softmax(logits, axis=-1).astype(v.dtype)
        return jnp.einsum('bqhk,bqkhd->bqhd', p, vg)

    def to_blocks(t):
        return jnp.swapaxes(t.reshape(bsz, n_blk, CHUNK, *t.shape[2:]), 0, 1)

    out = lax.map(block, (jnp.arange(n_blk), to_blocks(q), to_blocks(q_idx), to_blocks(w_idx)))
    return jnp.swapaxes(out, 0, 1).reshape(bsz, seq, A_WIDTH)


def gla_mixer(q, k, v, log_a):
    bsz, seq, nh, dk = q.shape
    nc = seq // CHUNK

    def chunks(t):
        return t.astype(jnp.float32).reshape(bsz, nc, CHUNK, nh, -1).transpose(1, 0, 3, 2, 4)

    qc = chunks(q) * dk ** -0.5
    kc, vc, gc = chunks(k), chunks(v), chunks(log_a)
    bcum = jnp.cumsum(gc, axis=3)
    blast = bcum[..., -1:, :]
    q_in = qc * jnp.exp(bcum)
    k_in = kc * jnp.exp(-bcum)
    k_dec = kc * jnp.exp(blast - bcum)
    causal = jnp.tril(jnp.ones((CHUNK, CHUNK), dtype=bool))
    att = jnp.where(causal, jnp.einsum('nbhtd,nbhsd->nbhts', q_in, k_in), 0.0)
    o_intra = jnp.einsum('nbhts,nbhsv->nbhtv', att, vc)

    def step(state, inp):
        qi, kd, vv, bl = inp
        o = jnp.einsum('bhtd,bhdv->bhtv', qi, state)
        state = state * jnp.exp(bl)[:, :, 0, :, None] + jnp.einsum('bhsd,bhsv->bhdv', kd, vv)
        return state, o

    s0 = jnp.zeros((bsz, nh, dk, vc.shape[-1]), jnp.float32)
    _, o_inter = lax.scan(step, s0, (q_in, k_dec, vc, blast))
    o = o_intra + o_inter
    return o.transpose(1, 0, 3, 2, 4).reshape(bsz, seq, nh, -1)


def setup_inputs(seed: int = 0) -> dict:
    key = jax.random.key(seed)
    ks = jax.random.split(key, 16)
    f32 = jnp.float32
    nrm = lambda k, shape, s: jax.random.normal(k, shape, f32) * s
    return {
        "x": nrm(ks[0], (BATCH, SEQ, D_MODEL), 1.0),
        "norm_mix": 1.0 + nrm(ks[1], (DEPTH, D_MODEL), 0.02),
        "w_in": nrm(ks[2], (DEPTH, D_MODEL, D_IN), D_MODEL ** -0.5),
        "w_gate_up": nrm(ks[3], (DEPTH, GATE_RANK, B_KEY_WIDTH), GATE_RANK ** -0.5),
        "b_gate": nrm(ks[4], (DEPTH, B_KEY_WIDTH), 0.01),
        "gla_norm": 1.0 + nrm(ks[5], (DEPTH, B_WIDTH), 0.02),
        "w_out": nrm(ks[6], (DEPTH, D_MIX, D_MODEL), D_MIX ** -0.5),
        "rel_bias": nrm(ks[7], (N_BUCKETS, A_HEADS), 0.2),
        "norm_ffn": 1.0 + nrm(ks[8], (DEPTH, D_MODEL), 0.02),
        "w_ffn_gate": nrm(ks[9], (DEPTH, D_MODEL, D_FF), D_MODEL ** -0.5),
        "w_ffn_up": nrm(ks[10], (DEPTH, D_MODEL, D_FF), D_MODEL ** -0.5),
        "w_ffn_down": nrm(ks[11], (DEPTH, D_FF, D_MODEL), D_FF ** -0.5),
        "norm_final": 1.0 + nrm(ks[12], (D_MODEL,), 0.02),
    }


def reference(x, norm_mix, w_in, w_gate_up, b_gate, gla_norm, w_out, rel_bias,
              norm_ffn, w_ffn_gate, w_ffn_up, w_ffn_down, norm_final):
    bsz, seq, _ = x.shape
    offsets = [int(o) for o in np.cumsum(SPLIT_SIZES)[:-1]]
    for l in range(DEPTH):
        h = rmsnorm(x, norm_mix[l])
        proj = h @ w_in[l]
        (qa, ka, va, qi, ki, wi, qb, kb, vb, gdown, ogate) = jnp.split(proj, offsets, axis=-1)
        o_a = dsa_mixer(qa.reshape(bsz, seq, A_HEADS, A_HEAD_DIM),
                        ka.reshape(bsz, seq, A_HEADS, A_HEAD_DIM),
                        va.reshape(bsz, seq, A_HEADS, A_HEAD_DIM),
                        qi.reshape(bsz, seq, IDX_HEADS, IDX_DIM), ki, wi, rel_bias)
        log_a = jax.nn.log_sigmoid((gdown @ w_gate_up[l] + b_gate[l]).astype(jnp.float32)) / GATE_NORMALIZER
        o_b = gla_mixer(qb.reshape(bsz, seq, B_HEADS, B_KEY_DIM),
                        kb.reshape(bsz, seq, B_HEADS, B_KEY_DIM),
                        vb.reshape(bsz, seq, B_HEADS, B_VAL_DIM),
                        log_a.reshape(bsz, seq, B_HEADS, B_KEY_DIM))
        o_b = rmsnorm(o_b, gla_norm[l].reshape(B_HEADS, B_VAL_DIM)).reshape(bsz, seq, B_WIDTH)
        o_b = (o_b * jax.nn.silu(ogate.astype(jnp.float32))).astype(x.dtype)
        mix = jnp.concatenate([o_a.astype(x.dtype), o_b], axis=-1) @ w_out[l]
        x = x + mix
        h = rmsnorm(x, norm_ffn[l])
        x = x + (jax.nn.silu(h @ w_ffn_gate[l]) * (h @ w_ffn_up[l])) @ w_ffn_down[l]
    return rmsnorm(x, norm_final)
```

```cpp
#include <hip/hip_runtime.h>
#include <cstdio>
#include <cstdint>
namespace pg8 {
#define PG8_LAS __attribute__((address_space(3)))
typedef unsigned short bf16_t;
typedef short bf16x8 __attribute__((ext_vector_type(8)));
typedef float f32x4 __attribute__((ext_vector_type(4)));
typedef unsigned u32x4 __attribute__((ext_vector_type(4)));
constexpr int BM = 256, BK = 64, HALF = 128, HTB = HALF * BK * 2  , STAGE_BYTES = 8 * HTB, NXCD = 8, WGM = 8;

__host__ __device__ __forceinline__ int lds_byte(int r, int c) { const int st = (r >> 4) * 2 + (c >> 5), rr = r & 15, cc = c & 31, ob = rr * 64 + cc * 2; return st * 1024 + (ob ^ (((ob >> 9) & 1) << 5)); }
__host__ __device__ __forceinline__ void stage_rc(int b, int& R, int& C) { const int st = b / 1024, sb = b % 1024, swz = sb ^ (((sb >> 9) & 1) << 5); R = (st >> 1) * 16 + swz / 64; C = (st & 1) * 32 + (swz % 64) / 2; }
__host__ __device__ __forceinline__ int perm32(int rho) { const int n = rho >> 4, i = rho & 15; return 8 * (i >> 2) + 4 * n + (i & 3); }

struct Unit { int pm, pn; };
struct Gemm { const bf16_t* A; const bf16_t* Bt; int M, N, K; };

struct StaticOrder {
    int nM, nN, nwg, G, c;
    __host__ __device__ void init(int M, int N, int G_, int c_) { nM = M / BM; nN = N / BM; nwg = nM * nN; G = G_; c = c_; }
    __host__ __device__ bool next(int i, Unit& u) const {
        const long L = (long)i * G + c; if (L >= nwg) return false;
        int wgid = (int)L; { const int q = nwg / NXCD, r = nwg % NXCD, xcd = wgid % NXCD, off = wgid / NXCD; wgid = (xcd < r ? xcd * (q + 1) : r * (q + 1) + (xcd - r) * q) + off; }
        const int nig = WGM * nN, gid = wgid / nig, fm = gid * WGM, gsz = (nM - fm) < WGM ? (nM - fm) : WGM;
        u.pm = fm + ((wgid % nig) % gsz); u.pn = (wgid % nig) / gsz; return true;
    }
    __device__ __forceinline__ void a_ready(const Unit&) const {}
    __device__ __forceinline__ void done(const Unit&) const {}
};

__device__ __forceinline__ unsigned cvt_pk_bf16(float lo, float hi) { unsigned r; asm volatile("v_cvt_pk_bf16_f32 %0, %1, %2" : "=v"(r) : "v"(lo), "v"(hi)); return r; }
typedef float f32x2 __attribute__((ext_vector_type(2)));
__device__ __forceinline__ f32x2 gelu_pk(f32x2 v) {
    const f32x2 av = __builtin_elementwise_abs(v), d = av * 0.2316418882f + 1.0f;
    f32x2 t; t.x = __builtin_amdgcn_rcpf(d.x); t.y = __builtin_amdgcn_rcpf(d.y);
    f32x2 q = t * 0.5307027145f + (-0.7265760135f); q = q * t + 0.7107068705f; q = q * t + (-0.142248368f); q = q * t + 0.127414796f; q = q * t;
    const f32x2 s = (v * v) * (-0.72134752044f);
    f32x2 e; e.x = __builtin_amdgcn_exp2f(s.x); e.y = __builtin_amdgcn_exp2f(s.y);
    const f32x2 m = v * (q * e), r = v - m;
    f32x2 o; o.x = v.x < 0.f ? m.x : r.x; o.y = v.y < 0.f ? m.y : r.y; return o;
}

template <int ACT  > struct EpiBf16 {
    static constexpr bool PERM = true, AFTER_DRAIN = false; static_assert(ACT == 0 || ACT == 1, "EpiBf16: ACT is 0 (none) or 1 (gelu_pk)");
    bf16_t* O; int ldc; const float* bias; int split_cols; size_t split_stride; float scale0;
    __device__ __forceinline__ void operator()(const f32x4 (&acc)[2][2][4][2], const Unit& u, int wr, int wc, int fr, int fq) const {
        const int row0 = u.pm * BM + wr * 64 + fr; int colt = u.pn * BM; bf16_t* base = O;
        float sc = 1.f; if (split_cols) { const int t = colt / split_cols; base += (size_t)t * split_stride; colt -= t * split_cols; if (t == 0) sc = scale0; }
        const int col0 = colt + wc * 32 + 8 * fq, bcol0 = u.pn * BM + wc * 32 + 8 * fq;
        f32x4 bv[2][2];
#pragma unroll
        for (int bj = 0; bj < 2; ++bj)
#pragma unroll
            for (int n = 0; n < 2; ++n) bv[bj][n] = bias ? *(const f32x4*)(bias + bcol0 + bj * HALF + 4 * n) : (f32x4){0.f, 0.f, 0.f, 0.f};
#pragma unroll
        for (int ai = 0; ai < 2; ++ai)
#pragma unroll
            for (int m = 0; m < 4; ++m) { bf16_t* rowp = base + (size_t)(row0 + ai * HALF + m * 16) * ldc + col0;
#pragma unroll
                for (int bj = 0; bj < 2; ++bj) { f32x4 v0 = acc[ai][bj][m][0] + bv[bj][0], v1 = acc[ai][bj][m][1] + bv[bj][1];
                    if (ACT == 1) { f32x2 a = gelu_pk((f32x2){v0[0], v0[1]}), b = gelu_pk((f32x2){v0[2], v0[3]}), c = gelu_pk((f32x2){v1[0], v1[1]}), d = gelu_pk((f32x2){v1[2], v1[3]});
                        v0 = (f32x4){a.x, a.y, b.x, b.y}; v1 = (f32x4){c.x, c.y, d.x, d.y}; }
                    v0 = v0 * sc; v1 = v1 * sc; u32x4 w; w.x = cvt_pk_bf16(v0[0], v0[1]); w.y = cvt_pk_bf16(v0[2], v0[3]); w.z = cvt_pk_bf16(v1[0], v1[1]); w.w = cvt_pk_bf16(v1[2], v1[3]);
                    *(u32x4*)(rowp + bj * HALF) = w; } }
    }
};
struct EpiOut {
    static constexpr bool PERM = true, AFTER_DRAIN = false;
    const float* x; float* x1; bf16_t* hn; const float* g; float* rs;
    __device__ __forceinline__ void operator()(const f32x4 (&acc)[2][2][4][2], const Unit& u, int wr, int wc, int fr, int fq) const {
        const int row0 = u.pm * BM + wr * 64 + fr, col0 = u.pn * BM + wc * 32 + 8 * fq;
        f32x4 gv[2][2];
#pragma unroll
        for (int bj = 0; bj < 2; ++bj)
#pragma unroll
            for (int n = 0; n < 2; ++n) gv[bj][n] = *(const f32x4*)(g + col0 + bj * HALF + 4 * n);
#pragma unroll
        for (int ai = 0; ai < 2; ++ai)
#pragma unroll
            for (int m = 0; m < 4; ++m) { const int row = row0 + ai * HALF + m * 16; const size_t off = (size_t)row * 1024 + col0; float ss = 0.f;
#pragma unroll
                for (int bj = 0; bj < 2; ++bj) {
                    const f32x4 xa = *(const f32x4*)(x + off + bj * HALF), xb = *(const f32x4*)(x + off + bj * HALF + 4);
                    const f32x4 v0 = acc[ai][bj][m][0] + xa, v1 = acc[ai][bj][m][1] + xb;
                    *(f32x4*)(x1 + off + bj * HALF) = v0; *(f32x4*)(x1 + off + bj * HALF + 4) = v1;
                    ss += (v0[0] * v0[0] + v0[1] * v0[1]) + (v0[2] * v0[2] + v0[3] * v0[3]) + (v1[0] * v1[0] + v1[1] * v1[1]) + (v1[2] * v1[2] + v1[3] * v1[3]);
                    const f32x4 h0 = v0 * gv[bj][0], h1 = v1 * gv[bj][1];
                    u32x4 w; w.x = cvt_pk_bf16(h0[0], h0[1]); w.y = cvt_pk_bf16(h0[2], h0[3]); w.z = cvt_pk_bf16(h1[0], h1[1]); w.w = cvt_pk_bf16(h1[2], h1[3]);
                    *(u32x4*)(hn + off + bj * HALF) = w; }
                ss += __shfl_xor(ss, 16); ss += __shfl_xor(ss, 32);
                if (fq == 0) rs[(size_t)row * 16 + u.pn * 4 + wc] = ss; }
    }
};
struct EpiGU {
    static constexpr bool PERM = true, AFTER_DRAIN = false;
    const float* rs; bf16_t* act; float eps;
    __device__ __forceinline__ void operator()(const f32x4 (&acc)[2][2][4][2], const Unit& u, int wr, int wc, int fr, int fq) const {
        const int row0 = u.pm * BM + wr * 64 + fr, col0 = u.pn * HALF + wc * 32 + 8 * fq;
#pragma unroll
        for (int ai = 0; ai < 2; ++ai)
#pragma unroll
            for (int m = 0; m < 4; ++m) { const int row = row0 + ai * HALF + m * 16;
                const f32x4* rp = (const f32x4*)(rs + (size_t)row * 16); const f32x4 p0 = rp[0], p1 = rp[1], p2 = rp[2], p3 = rp[3];
                const float ssq = ((p0[0] + p0[1]) + (p0[2] + p0[3])) + ((p1[0] + p1[1]) + (p1[2] + p1[3])) + ((p2[0] + p2[1]) + (p2[2] + p2[3])) + ((p3[0] + p3[1]) + (p3[2] + p3[3]));
                const float r = 1.0f / sqrtf(ssq * (1.0f / 1024.0f) + eps);
                float a[8];
#pragma unroll
                for (int n = 0; n < 2; ++n)
#pragma unroll
                    for (int j = 0; j < 4; ++j) { const float gg = acc[ai][0][m][n][j] * r, uu = acc[ai][1][m][n][j] * r;
                        a[4 * n + j] = gg * __builtin_amdgcn_rcpf(1.0f + __builtin_amdgcn_exp2f(gg * -1.44269504f)) * uu; }
                u32x4 w; w.x = cvt_pk_bf16(a[0], a[1]); w.y = cvt_pk_bf16(a[2], a[3]); w.z = cvt_pk_bf16(a[4], a[5]); w.w = cvt_pk_bf16(a[6], a[7]);
                *(u32x4*)(act + (size_t)row * 2816 + col0) = w; }
    }
};
struct EpiDown {
    static constexpr bool PERM = true, AFTER_DRAIN = false;
    float* xio; float* rs;
    __device__ __forceinline__ void operator()(const f32x4 (&acc)[2][2][4][2], const Unit& u, int wr, int wc, int fr, int fq) const {
        const int row0 = u.pm * BM + wr * 64 + fr, col0 = u.pn * BM + wc * 32 + 8 * fq;
#pragma unroll
        for (int ai = 0; ai < 2; ++ai)
#pragma unroll
            for (int m = 0; m < 4; ++m) { const int row = row0 + ai * HALF + m * 16; const size_t off = (size_t)row * 1024 + col0; float ss = 0.f;
#pragma unroll
                for (int bj = 0; bj < 2; ++bj) {
                    const f32x4 xa = *(const f32x4*)(xio + off + bj * HALF), xb = *(const f32x4*)(xio + off + bj * HALF + 4);
                    const f32x4 v0 = acc[ai][bj][m][0] + xa, v1 = acc[ai][bj][m][1] + xb;
                    *(f32x4*)(xio + off + bj * HALF) = v0; *(f32x4*)(xio + off + bj * HALF + 4) = v1;
                    ss += (v0[0] * v0[0] + v0[1] * v0[1]) + (v0[2] * v0[2] + v0[3] * v0[3]) + (v1[0] * v1[0] + v1[1] * v1[1]) + (v1[2] * v1[2] + v1[3] * v1[3]); }
                ss += __shfl_xor(ss, 16); ss += __shfl_xor(ss, 32);
                if (fq == 0) rs[(size_t)row * 16 + u.pn * 4 + wc] = ss; }
    }
};
template <class Epi, class Sched, bool ALIGN_EPI = false, bool SP2 = false>
__device__ __forceinline__ void gemm_phase(PG8_LAS unsigned char* lds, const Gemm g, const Sched& S, const Epi& E) {
    const int tid = threadIdx.x, wid = __builtin_amdgcn_readfirstlane(tid >> 6), lane = tid & 63, wr = wid >> 2, wc = wid & 3, fr = lane & 15, fq = lane >> 4;
    const int K = g.K, nt = K / BK;
    unsigned voffA[2], voffB[2];
#pragma unroll
    for (int i = 0; i < 2; ++i) { int R, C; stage_rc(tid * 16 + i * 8192, R, C); const int Rb = Epi::PERM ? ((R & ~31) + perm32(R & 31)) : R;
        voffA[i] = (unsigned)(R * K + C) * 2u; voffB[i] = (unsigned)(Rb * K + C) * 2u; }
    const size_t kstep = (size_t)(BK * 2);
    const size_t hstep = (size_t)HALF * K * 2;
    const size_t tstep = 2 * hstep;
    const unsigned ldsw = (unsigned)wid * 1024u;
    const int aoff = lds_byte(wr * 64 + fr, fq * 8), boff = lds_byte(wc * 32 + fr, fq * 8);
#define PG8_SA(b, h) (((b) * 2 + (h)) * HTB)
#define PG8_SB(b, h) ((4 + (b) * 2 + (h)) * HTB)
#define PG8_STAGE(bufoff, gbase, voff) do { _Pragma("unroll") for (int _i = 0; _i < 2; ++_i) \
        __builtin_amdgcn_global_load_lds((const unsigned*)((const char*)(gbase) + (voff)[_i]), (PG8_LAS unsigned*)(lds + (bufoff) + ldsw + _i * 8192), 16, 0, 0); } while (0)
#define PG8_LDA(dst, b, h) do { _Pragma("unroll") for (int m = 0; m < 4; ++m) _Pragma("unroll") for (int k = 0; k < 2; ++k) dst[m][k] = *(const PG8_LAS bf16x8*)(lds + PG8_SA(b, h) + aoff + m * 2048 + k * 1024); } while (0)
#define PG8_LDB(dst, b, h) do { _Pragma("unroll") for (int n = 0; n < 2; ++n) _Pragma("unroll") for (int k = 0; k < 2; ++k) dst[n][k] = *(const PG8_LAS bf16x8*)(lds + PG8_SB(b, h) + boff + n * 2048 + k * 1024); } while (0)
#define PG8_MMA(ai, bj, At, Bt) do { __builtin_amdgcn_s_setprio(1); _Pragma("unroll") for (int m = 0; m < 4; ++m) _Pragma("unroll") for (int n = 0; n < 2; ++n) _Pragma("unroll") for (int k = 0; k < 2; ++k) \
        acc[ai][bj][m][n] = __builtin_amdgcn_mfma_f32_16x16x32_bf16(Bt[n][k], At[m][k], acc[ai][bj][m][n], 0, 0, 0); __builtin_amdgcn_s_setprio(0); } while (0)
#define PG8_WAIT_V(n) asm volatile("s_waitcnt vmcnt(" #n ")" ::: "memory")
#define PG8_WAIT_L(n) asm volatile("s_waitcnt lgkmcnt(" #n ")" ::: "memory")
#define PG8_BAR __builtin_amdgcn_s_barrier()
#define PG8_SCHED __builtin_amdgcn_sched_barrier(0)
    Unit cur, nxt; int ui = 0;
    if (!S.next(0, cur)) return;
    f32x4 acc[2][2][4][2];
#pragma unroll
    for (int a = 0; a < 2; ++a)
#pragma unroll
        for (int b = 0; b < 2; ++b)
#pragma unroll
            for (int m = 0; m < 4; ++m)
#pragma unroll
                for (int n = 0; n < 2; ++n) acc[a][b][m][n] = (f32x4){0.f, 0.f, 0.f, 0.f};
    bf16x8 At[4][2], B0[2][2], B1[2][2];
    const char* cA = (const char*)g.A + (size_t)cur.pm * tstep; const char* cB = (const char*)g.Bt + (size_t)cur.pn * tstep;
    S.a_ready(cur);
    if constexpr (SP2) {
        PG8_STAGE(PG8_SB(0, 0), cB, voffB); PG8_STAGE(PG8_SB(0, 1), cB + hstep, voffB); PG8_STAGE(PG8_SA(0, 0), cA, voffA); PG8_STAGE(PG8_SA(0, 1), cA + hstep, voffA);
        if (wr == 1) PG8_BAR;
        PG8_WAIT_V(2); PG8_BAR;
        PG8_STAGE(PG8_SB(1, 0), cB + kstep, voffB); PG8_STAGE(PG8_SA(1, 0), cA + kstep, voffA); PG8_STAGE(PG8_SB(1, 1), cB + hstep + kstep, voffB);
        PG8_WAIT_V(6); PG8_BAR;
    } else {
        PG8_STAGE(PG8_SB(0, 0), cB, voffB); PG8_STAGE(PG8_SA(0, 0), cA, voffA); PG8_STAGE(PG8_SB(0, 1), cB + hstep, voffB); PG8_STAGE(PG8_SA(0, 1), cA + hstep, voffA);
        if (wr == 1) PG8_BAR;
        PG8_WAIT_V(4); PG8_BAR;
        PG8_STAGE(PG8_SB(1, 0), cB + kstep, voffB); PG8_STAGE(PG8_SA(1, 0), cA + kstep, voffA); PG8_STAGE(PG8_SB(1, 1), cB + hstep + kstep, voffB);
        PG8_WAIT_V(6); PG8_BAR;
    }
    for (;;) {
        const bool has_next = S.next(ui + 1, nxt);
        const char* nA = has_next ? (const char*)g.A + (size_t)nxt.pm * tstep : cA; const char* nB = has_next ? (const char*)g.Bt + (size_t)nxt.pn * tstep : cB;
        for (int t = 0; t < nt; t += 2) {
            const bool last = (t == nt - 2);
            const char* a1 = cA + (size_t)(t + 1) * kstep;
            const char* a2 = last ? nA : cA + (size_t)(t + 2) * kstep; const char* b2 = last ? nB : cB + (size_t)(t + 2) * kstep;
            const char* a3 = a2 + kstep; const char* b3 = b2 + kstep;
            if (last && has_next) S.a_ready(nxt);
            if constexpr (SP2) {
            PG8_LDB(B0, 0, 0); PG8_LDB(B1, 0, 1); PG8_SCHED; PG8_LDA(At, 0, 0); PG8_STAGE(PG8_SA(1, 1), a1 + hstep, voffA);
            PG8_WAIT_V(8); PG8_WAIT_L(0); PG8_BAR; PG8_MMA(0, 0, At, B0); PG8_MMA(0, 1, At, B1); PG8_BAR; PG8_SCHED;
            PG8_LDA(At, 0, 1); PG8_STAGE(PG8_SB(0, 0), b2, voffB); PG8_STAGE(PG8_SB(0, 1), b2 + hstep, voffB); PG8_STAGE(PG8_SA(0, 0), a2, voffA);
            PG8_WAIT_V(8); PG8_WAIT_L(0); PG8_BAR; PG8_MMA(1, 0, At, B0); PG8_MMA(1, 1, At, B1); PG8_BAR; PG8_SCHED;
            PG8_LDB(B0, 1, 0); PG8_LDB(B1, 1, 1); PG8_SCHED; PG8_LDA(At, 1, 0); PG8_STAGE(PG8_SA(0, 1), a2 + hstep, voffA);
            PG8_WAIT_V(8); PG8_WAIT_L(0); PG8_BAR; PG8_MMA(0, 0, At, B0); PG8_MMA(0, 1, At, B1); PG8_BAR; PG8_SCHED;
            PG8_LDA(At, 1, 1); PG8_STAGE(PG8_SB(1, 0), b3, voffB); PG8_STAGE(PG8_SB(1, 1), b3 + hstep, voffB); PG8_STAGE(PG8_SA(1, 0), a3, voffA);
            PG8_WAIT_V(8); PG8_WAIT_L(0); PG8_BAR; PG8_MMA(1, 0, At, B0); PG8_MMA(1, 1, At, B1); PG8_BAR; PG8_SCHED;
            } else {
            PG8_LDB(B0, 0, 0); PG8_SCHED; PG8_LDA(At, 0, 0); PG8_STAGE(PG8_SA(1, 1), a1 + hstep, voffA);
            PG8_WAIT_L(8); PG8_BAR; PG8_WAIT_L(0); PG8_MMA(0, 0, At, B0); PG8_BAR; PG8_SCHED;
            PG8_LDB(B1, 0, 1); PG8_STAGE(PG8_SB(0, 0), b2, voffB);
            PG8_BAR; PG8_WAIT_L(0); PG8_MMA(0, 1, At, B1); PG8_BAR;
            PG8_LDA(At, 0, 1); PG8_STAGE(PG8_SA(0, 0), a2, voffA);
            PG8_BAR; PG8_WAIT_L(0); PG8_MMA(1, 0, At, B0); PG8_BAR; PG8_SCHED;
            PG8_STAGE(PG8_SB(0, 1), b2 + hstep, voffB);
            PG8_WAIT_V(6); PG8_BAR; PG8_MMA(1, 1, At, B1); PG8_BAR;
            PG8_LDB(B0, 1, 0); PG8_SCHED; PG8_LDA(At, 1, 0); PG8_STAGE(PG8_SA(0, 1), a2 + hstep, voffA);
            PG8_WAIT_L(8); PG8_BAR; PG8_WAIT_L(0); PG8_MMA(0, 0, At, B0); PG8_BAR; PG8_SCHED;
            PG8_LDB(B1, 1, 1); PG8_STAGE(PG8_SB(1, 0), b3, voffB);
            PG8_BAR; PG8_WAIT_L(0); PG8_MMA(0, 1, At, B1); PG8_BAR;
            PG8_LDA(At, 1, 1); PG8_STAGE(PG8_SA(1, 0), a3, voffA);
            PG8_BAR; PG8_WAIT_L(0); PG8_MMA(1, 0, At, B0); PG8_BAR; PG8_SCHED;
            PG8_STAGE(PG8_SB(1, 1), b3 + hstep, voffB);
            PG8_WAIT_V(6); PG8_BAR; PG8_MMA(1, 1, At, B1); PG8_BAR;
            }
        }
        if constexpr (ALIGN_EPI) { if (wr == 0) PG8_BAR; }
        if constexpr (!Epi::AFTER_DRAIN) { E(acc, cur, wr, wc, fr, fq); S.done(cur); }
        if (!has_next) break;
#pragma unroll
        for (int a = 0; a < 2; ++a)
#pragma unroll
            for (int b = 0; b < 2; ++b)
#pragma unroll
                for (int m = 0; m < 4; ++m)
#pragma unroll
                    for (int n = 0; n < 2; ++n) acc[a][b][m][n] = (f32x4){0.f, 0.f, 0.f, 0.f};
        cur = nxt; cA = nA; cB = nB; ++ui;
        if constexpr (ALIGN_EPI) { if (wr == 1) PG8_BAR; }
    }
    PG8_WAIT_V(0);
    if constexpr (!ALIGN_EPI) { if (wr == 0) PG8_BAR; }
    PG8_BAR;
    if constexpr (Epi::AFTER_DRAIN) { E.fused(acc, cur, wr, wc, fr, fq, lds, wid, lane); S.done(cur); }
#undef PG8_SA
#undef PG8_SB
#undef PG8_STAGE
#undef PG8_LDA
#undef PG8_LDB
#undef PG8_MMA
#undef PG8_WAIT_V
#undef PG8_WAIT_L
#undef PG8_BAR
#undef PG8_SCHED
}
}
#define LAS __attribute__((address_space(3)))
#define XB_TMO      128
#define XB_XCNT(j)  (256  + 64 * (j))
#define XB_XSUB(j)  (1280 + 64 * (j))
#define XB_XGEN(j)  (2304 + 64 * (j))
#define XB_TOP      3328
#define XB_TOPGEN   3392
#define XCD_BAR_WORDS 3456
#define XB_SPIN_CAP (1u << 18)

__device__ __forceinline__ unsigned xb_ld(unsigned* p)              { return __hip_atomic_load(p, __ATOMIC_RELAXED, __HIP_MEMORY_SCOPE_AGENT); }
__device__ __forceinline__ unsigned xb_add(unsigned* p, unsigned v) { return __hip_atomic_fetch_add(p, v, __ATOMIC_RELAXED, __HIP_MEMORY_SCOPE_AGENT); }
__device__ __forceinline__ unsigned xb_xcc_id() { return (unsigned)__builtin_amdgcn_s_getreg((3 << 11) | 20) & 0xFu; }
#define XB_SPIN(cond, bar) do { unsigned _sp = 0; while (cond) { __builtin_amdgcn_s_sleep(1); \
    if ((++_sp & 255u) == 0u) { if (xb_ld(&(bar)[XB_TMO])) break; if (_sp > XB_SPIN_CAP) { atomicAdd(&(bar)[XB_TMO], 1u); break; } } } } while (0)

struct XcdBarrier {
    unsigned* bar; unsigned x;
    volatile LAS unsigned* st;
};

__device__ __forceinline__ XcdBarrier xcd_barrier_post(unsigned* bar, volatile LAS unsigned* st) {
    XcdBarrier b; b.bar = bar; b.x = xb_xcc_id(); b.st = st;
    if (threadIdx.x == 0) (void)xb_add(&bar[XB_XCNT(b.x)], 1u);
    return b;
}
__device__ __forceinline__ void xcd_barrier_complete(unsigned* bar, unsigned x, unsigned& nloc, unsigned& nx) {
    const unsigned G = gridDim.x * gridDim.y * gridDim.z;
    unsigned sum, cnt, mine, sp = 0u;
    for (;;) {
        sum = 0u; cnt = 0u; mine = 0u;
#pragma unroll
        for (unsigned j = 0; j < 16; ++j) { const unsigned c = xb_ld(&bar[XB_XCNT(j)]); sum += c; cnt += (c > 0u) ? 1u : 0u; mine = (j == x) ? c : mine; }
        if (sum == G) break;
        __builtin_amdgcn_s_sleep(1);
        if ((++sp & 255u) == 0u) { if (xb_ld(&bar[XB_TMO])) break; if (sp > XB_SPIN_CAP) { atomicAdd(&bar[XB_TMO], 1u); break; } }
    }
    nloc = mine > 0u ? mine : 1u; nx = cnt > 0u ? cnt : 1u;
}

__device__ __forceinline__ void xcd_barrier(const XcdBarrier& b) {
    asm volatile("s_waitcnt vmcnt(0)" ::: "memory");
    __syncthreads();
    if (threadIdx.x == 0) {
        unsigned* bar = b.bar;
        __builtin_amdgcn_s_waitcnt(0);
        unsigned nloc = b.st[0], nx = b.st[1];
        if (nloc == 0u) { xcd_barrier_complete(bar, b.x, nloc, nx); b.st[0] = nloc; b.st[1] = nx; }
        const unsigned old = xb_add(&bar[XB_XSUB(b.x)], 1u);
        const unsigned gen = old / nloc;
        if (old + 1u == (gen + 1u) * nloc) {
            __builtin_amdgcn_fence(__ATOMIC_RELEASE, "agent");
            asm volatile("s_waitcnt vmcnt(0)" ::: "memory");
            const unsigned og = xb_add(&bar[XB_TOP], 1u);
            const unsigned tg = og / nx;
            if (og + 1u == (tg + 1u) * nx) xb_add(&bar[XB_TOPGEN], 1u);
            else XB_SPIN(xb_ld(&bar[XB_TOPGEN]) == tg, bar);
            __builtin_amdgcn_fence(__ATOMIC_ACQUIRE, "agent");
            xb_add(&bar[XB_XGEN(b.x)], 1u);
            asm volatile("s_waitcnt vmcnt(0)" ::: "memory");
        } else {
            XB_SPIN(xb_ld(&bar[XB_XGEN(b.x)]) == gen, bar);
            __builtin_amdgcn_fence(__ATOMIC_ACQUIRE, "agent");
            asm volatile("s_waitcnt vmcnt(0)" ::: "memory");
        }
    }
    __syncthreads();
}
constexpr int NWAVES = 8;
#ifndef MK_N_LAUNCHES
#define MK_N_LAUNCHES 1
#endif
constexpr int N_PHASES = 7;
constexpr int N_LAUNCHES = MK_N_LAUNCHES;

constexpr int BATCH = 16, SEQ = 2048, D = 1024, M = BATCH * SEQ;
constexpr int CHUNK = 64, NCHUNK = SEQ / CHUNK;
constexpr int D_IN = 3384, NPROJ = 3584;
constexpr int FF = 2816, NGU = 2 * FF;
constexpr float EPS = 1e-6f;
constexpr int C_QA = 0, C_KA = 512, C_VA = 1024, C_QI = 1536, C_QB = 1792, C_KB = 2048, C_VB = 2304, C_OG = 2816, C_KI = 3328, C_WI = 3360, C_GD = 3368;
__host__ __device__ __forceinline__ int in_src(int r) {
    if (r < 1792) return r;
    if (r < 2048) return 1832 + (r - 1792);
    if (r < 2304) return 2088 + (r - 2048);
    if (r < 2816) return 2344 + (r - 2304);
    if (r < 3328) return 2872 + (r - 2816);
    if (r < 3360) return 1792 + (r - 3328);
    if (r < 3368) return 1824 + (r - 3360);
    if (r < 3384) return 2856 + (r - 3368);
    return -1;
}

constexpr size_t MiB = 1u << 20;
constexpr size_t WS_CTL = 0, CTL_ZERO_BYTES = 1 * MiB;
constexpr size_t WS_WIN = 2 * MiB;
constexpr size_t WS_WOUT = 9 * MiB;
constexpr size_t WS_WGU = 11 * MiB;
constexpr size_t WS_WDN = 22 * MiB;
constexpr size_t WS_RS1 = 28 * MiB;
constexpr size_t WS_RS2 = 30 * MiB;
constexpr size_t WS_H = 40 * MiB;
constexpr size_t WS_PROJ = 104 * MiB;
constexpr size_t WS_MIX = 328 * MiB;
constexpr size_t WS_END = 392 * MiB;
constexpr int CW_BAR = 4096;

constexpr int RING_OFF = 0, RING_BYTES = 131072;
constexpr int LDSCTL_OFF = RING_BYTES, MISC_OFF = LDSCTL_OFF + 320;
constexpr int LDS_BYTES = 147456;

#define GAS __attribute__((address_space(1)))
#ifndef LAS
#define LAS __attribute__((address_space(3)))
#endif
typedef unsigned short bf16;
typedef unsigned v4u __attribute__((ext_vector_type(4)));
typedef unsigned v2u __attribute__((ext_vector_type(2)));
typedef float f32x4 __attribute__((ext_vector_type(4)));
#define LDS_WAIT() asm volatile("s_waitcnt lgkmcnt(0)" ::: "memory")
#define VM_WAIT() asm volatile("s_waitcnt vmcnt(0)" ::: "memory")
__device__ __forceinline__ unsigned f2bf(float f) { unsigned u = __builtin_bit_cast(unsigned, f); return (u + 0x7fffu + ((u >> 16) & 1u)) >> 16; }
__device__ __forceinline__ unsigned pk2(float lo, float hi) { return f2bf(lo) | (f2bf(hi) << 16); }
__device__ __forceinline__ float bf2f(unsigned short b) { return __builtin_bit_cast(float, (unsigned)b << 16); }
__device__ __forceinline__ float bflo(unsigned w) { return __builtin_bit_cast(float, w << 16); }
__device__ __forceinline__ float bfhi(unsigned w) { return __builtin_bit_cast(float, w & 0xffff0000u); }

struct Frame {
    LAS unsigned char* lds;
    volatile LAS unsigned* MISC;
    unsigned* ctl;
    int tid, lane, wave, G;
    const float *x, *norm_mix, *w_in, *w_gate_up, *b_gate, *gla_norm, *w_out, *rel_bias, *norm_ffn, *w_ffn_gate, *w_ffn_up, *w_ffn_down, *norm_final;
    float* out;
    bf16 *WIN, *WOUT, *WGU, *WDN, *H, *PROJ, *MIX, *ACT;
    float *RS1, *RS2;
};

__device__ __forceinline__ float wave_sum(float v) {
#pragma unroll
    for (int o = 1; o < 64; o <<= 1) v += __shfl_xor(v, o);
    return v;
}
__device__ __forceinline__ float wave_max(float v) {
#pragma unroll
    for (int o = 1; o < 64; o <<= 1) v = fmaxf(v, __shfl_xor(v, o));
    return v;
}
__device__ __forceinline__ int wave_sum_i(int v) {
#pragma unroll
    for (int o = 1; o < 64; o <<= 1) v += __shfl_xor(v, o);
    return v;
}

__device__ __forceinline__ void p0_item(const float* cp, int ld, bf16* WT, int K, int r0, int k0, LAS float* scr, int lane) {
#pragma unroll 8
    for (int i = 0; i < 32; ++i) { const int kk = 2 * i + (lane >> 5); scr[kk * 33 + (lane & 31)] = cp ? cp[(size_t)(k0 + kk) * ld] : 0.f; }
    LDS_WAIT(); asm volatile("" ::: "memory");
    const int c = lane & 7;
#pragma unroll
    for (int j = 0; j < 4; ++j) { const int n = (lane >> 3) + 8 * j; const LAS float* s = scr + (8 * c) * 33 + n;
        v4u o; o.x = pk2(s[0 * 33], s[1 * 33]); o.y = pk2(s[2 * 33], s[3 * 33]); o.z = pk2(s[4 * 33], s[5 * 33]); o.w = pk2(s[6 * 33], s[7 * 33]);
        *(v4u*)(WT + (size_t)(r0 + n) * K + k0 + 8 * c) = o; }
    LDS_WAIT(); asm volatile("" ::: "memory");
}
__device__ __forceinline__ void p0_prologue(Frame& F) {
    LAS float* scr = (LAS float*)(F.lds + RING_OFF + F.wave * 16384);
    const int gw = blockIdx.x * NWAVES + F.wave, NGW = F.G * NWAVES, lane = F.lane;
    constexpr int I_IN = (D / 64) * (NPROJ / 32), I_OUT = (D / 64) * (D / 32), I_GU = (D / 64) * (NGU / 32), I_DN = (FF / 64) * (D / 32);
    constexpr int NITEMS = I_IN + I_OUT + I_GU + I_DN;
    for (int it = gw; it < NITEMS; it += NGW) {
        int r = it;
        if (r < I_IN) { const int kb = r / (NPROJ / 32), nb = r % (NPROJ / 32); const int sc = in_src(32 * nb + (lane & 31));
            p0_item(sc >= 0 ? F.w_in + sc : nullptr, D_IN, F.WIN, D, 32 * nb, 64 * kb, scr, lane); continue; }
        r -= I_IN;
        if (r < I_OUT) { const int kb = r / (D / 32), nb = r % (D / 32);
            p0_item(F.w_out + 32 * nb + (lane & 31), D, F.WOUT, D, 32 * nb, 64 * kb, scr, lane); continue; }
        r -= I_OUT;
        if (r < I_GU) { const int kb = r / (NGU / 32), nb = r % (NGU / 32); const int rr = 32 * nb + (lane & 31), t = rr >> 8, j = rr & 255;
            const float* cp = (j < 128) ? F.w_ffn_gate + 128 * t + j : F.w_ffn_up + 128 * t + (j - 128);
            p0_item(cp, FF, F.WGU, D, 32 * nb, 64 * kb, scr, lane); continue; }
        r -= I_GU;
        { const int kb = r / (D / 32), nb = r % (D / 32);
            p0_item(F.w_ffn_down + 32 * nb + (lane & 31), D, F.WDN, FF, 32 * nb, 64 * kb, scr, lane); }
    }
    for (int m = gw; m < M; m += NGW) {
        const f32x4* xr = (const f32x4*)(F.x + (size_t)m * D) + lane; const f32x4* gr = (const f32x4*)F.norm_mix + lane;
        f32x4 v[4]; float s = 0.f;
#pragma unroll
        for (int j = 0; j < 4; ++j) { v[j] = xr[64 * j]; s += (v[j].x * v[j].x + v[j].y * v[j].y) + (v[j].z * v[j].z + v[j].w * v[j].w); }
        const float r = 1.0f / sqrtf(wave_sum(s) * (1.0f / D) + EPS);
        v2u* o8 = (v2u*)(F.H + (size_t)m * D) + lane;
#pragma unroll
        for (int j = 0; j < 4; ++j) { const f32x4 g = gr[64 * j]; v2u w; w.x = pk2(v[j].x * r * g.x, v[j].y * r * g.y); w.y = pk2(v[j].z * r * g.z, v[j].w * r * g.w); o8[64 * j] = w; }
    }
}

__device__ __forceinline__ int t5_bucket(int rel) {
    const int ret = rel > 0 ? 16 : 0; const int n = rel < 0 ? -rel : rel;
    const int v = n < 8 ? n : n < 12 ? 8 : n < 16 ? 9 : n < 23 ? 10 : n < 32 ? 11 : n < 46 ? 12 : n < 64 ? 13 : n < 91 ? 14 : 15;
    return ret + v;
}
__device__ __forceinline__ unsigned ord_key(float s) { const unsigned b = __builtin_bit_cast(unsigned, s + 0.0f); return (b & 0x80000000u) ? ~b : (b | 0x80000000u); }

__device__ __forceinline__ void dsa_simple(Frame& F) {
    LAS unsigned char* wl = F.lds + RING_OFF + F.wave * 16384;
    LAS float* sc = (LAS float*)wl;
    LAS float* qs = (LAS float*)(wl + 8192);
    LAS float* wq = (LAS float*)(wl + 9216);
    LAS unsigned* list = (LAS unsigned*)(wl + 9472);
    LAS float* pl = (LAS float*)(wl + 10496);
    LAS float* qh = (LAS float*)(wl + 11520);
    const int lane = F.lane, gw = blockIdx.x * NWAVES + F.wave, NGW = F.G * NWAVES;
    const unsigned long long lt = (1ull << lane) - 1ull;
    for (int w = gw; w < M; w += NGW) {
        const int b = w / SEQ, t = ((w % SEQ) + 131 * b) % SEQ, n = t >> 6, L = (n + 1) * CHUNK, nj = n + 1;
        const size_t m = (size_t)b * SEQ + t;
        const bf16* prow = F.PROJ + m * NPROJ;
        { const v2u qv = *(const v2u*)(prow + C_QI + 4 * lane); qs[4 * lane] = bflo(qv.x); qs[4 * lane + 1] = bfhi(qv.x); qs[4 * lane + 2] = bflo(qv.y); qs[4 * lane + 3] = bfhi(qv.y);
          if (lane < 8) wq[lane] = bf2f(prow[C_WI + lane]) * 0.0625f; }
        LDS_WAIT(); asm volatile("" ::: "memory");
        for (int j = 0; j < nj; ++j) {
            const int key = j * 64 + lane; const v4u* kp = (const v4u*)(F.PROJ + ((size_t)b * SEQ + key) * NPROJ + C_KI);
            float ki[32];
#pragma unroll
            for (int q = 0; q < 4; ++q) { const v4u kv = kp[q]; ki[8 * q] = bflo(kv.x); ki[8 * q + 1] = bfhi(kv.x); ki[8 * q + 2] = bflo(kv.y); ki[8 * q + 3] = bfhi(kv.y);
                ki[8 * q + 4] = bflo(kv.z); ki[8 * q + 5] = bfhi(kv.z); ki[8 * q + 6] = bflo(kv.w); ki[8 * q + 7] = bfhi(kv.w); }
            float s = 0.f;
#pragma unroll 1
            for (int h = 0; h < 8; ++h) { float d = 0.f;
#pragma unroll
                for (int dd = 0; dd < 32; ++dd) d += qs[h * 32 + dd] * ki[dd];
                s += wq[h] * fmaxf(d, 0.f); }
            sc[key] = s;
        }
        LDS_WAIT(); asm volatile("" ::: "memory");
        unsigned selbits = 0u;
        if (L <= 256) selbits = (1u << nj) - 1u;
        else {
            unsigned u[32];
#pragma unroll
            for (int j = 0; j < 32; ++j) u[j] = (j < nj) ? ord_key(sc[j * 64 + lane]) : 0u;
            unsigned T = 0u;
            for (int bit = 31; bit >= 0; --bit) { const unsigned cand = T | (1u << bit); int c = 0;
#pragma unroll
                for (int j = 0; j < 32; ++j) c += (u[j] >= cand) ? 1 : 0;
                c = wave_sum_i(c); if (c >= 256) T = cand; }
            int cg = 0;
#pragma unroll
            for (int j = 0; j < 32; ++j) cg += (u[j] > T) ? 1 : 0;
            cg = wave_sum_i(cg); const int r = 256 - cg; int run = 0;
#pragma unroll
            for (int j = 0; j < 32; ++j) { const bool eq = (u[j] == T); const unsigned long long em = __ballot(eq); const int pre = run + __popcll(em & lt);
                if ((u[j] > T) || (eq && pre < r)) selbits |= (1u << j); run += __popcll(em); }
        }
        int nsel = 0;
#pragma unroll
        for (int j = 0; j < 32; ++j) { const bool s = (selbits >> j) & 1u; const unsigned long long mk = __ballot(s); if (s) list[nsel + __popcll(mk & lt)] = (unsigned)(j * 64 + lane); nsel += __popcll(mk); }
        LDS_WAIT(); asm volatile("" ::: "memory");
        for (int h = 0; h < 8; ++h) {
            qh[lane] = bf2f(prow[C_QA + h * 64 + lane]);
            LDS_WAIT(); asm volatile("" ::: "memory");
            float lg[4]; float mx = -1e30f;
#pragma unroll
            for (int c = 0; c < 4; ++c) { const int idx = c * 64 + lane; lg[c] = -1e30f;
                if (idx < nsel) { const int key = (int)list[idx]; const v4u* kp = (const v4u*)(F.PROJ + ((size_t)b * SEQ + key) * NPROJ + C_KA + h * 64); float d = 0.f;
#pragma unroll
                    for (int q = 0; q < 8; ++q) { const v4u kv = kp[q]; d += qh[8 * q] * bflo(kv.x) + qh[8 * q + 1] * bfhi(kv.x) + qh[8 * q + 2] * bflo(kv.y) + qh[8 * q + 3] * bfhi(kv.y)
                        + qh[8 * q + 4] * bflo(kv.z) + qh[8 * q + 5] * bfhi(kv.z) + qh[8 * q + 6] * bflo(kv.w) + qh[8 * q + 7] * bfhi(kv.w); }
                    lg[c] = d * 0.125f + F.rel_bias[t5_bucket(key - t) * 8 + h]; }
                mx = fmaxf(mx, lg[c]); }
            mx = wave_max(mx); float sum = 0.f;
#pragma unroll
            for (int c = 0; c < 4; ++c) { const int idx = c * 64 + lane; lg[c] = (idx < nsel) ? __expf(lg[c] - mx) : 0.f; sum += lg[c]; }
            sum = wave_sum(sum); const float inv = 1.0f / sum;
#pragma unroll
            for (int c = 0; c < 4; ++c) pl[c * 64 + lane] = lg[c] * inv;
            LDS_WAIT(); asm volatile("" ::: "memory");
            float o = 0.f;
            for (int i = 0; i < nsel; ++i) { const int key = (int)list[i]; o += pl[i] * bf2f(F.PROJ[((size_t)b * SEQ + key) * NPROJ + C_VA + h * 64 + lane]); }
            F.MIX[m * D + h * 64 + lane] = (bf16)f2bf(o);
            LDS_WAIT(); asm volatile("" ::: "memory");
        }
    }
}

__device__ __forceinline__ void gla_simple(Frame& F) {
    LAS float* qin = (LAS float*)(F.lds + RING_OFF);
    LAS float* kin = qin + 64 * 65;
    LAS float* att = kin + 64 * 65;
    LAS float* vv = att + 64 * 65;
    LAS float* S = vv + 64 * 128;
    LAS float* gd = S + 64 * 128;
    LAS float* Wg = gd + 64 * 16;
    LAS float* bg = Wg + 16 * 64;
    LAS float* ebl = bg + 64;
    const int tid = F.tid, lane = F.lane, wave = F.wave;
    for (int unit = blockIdx.x; unit < BATCH * 4; unit += F.G) {
        const int b = unit >> 2, h = unit & 3;
        for (int e = tid; e < 1024; e += 512) Wg[e] = F.w_gate_up[(e >> 6) * 256 + h * 64 + (e & 63)];
        if (tid < 64) bg[tid] = F.b_gate[h * 64 + tid];
        for (int e = tid; e < 8192; e += 512) S[e] = 0.f;
        __syncthreads();
        for (int n = 0; n < NCHUNK; ++n) {
            const size_t tok0 = (size_t)b * SEQ + n * CHUNK;
            for (int e = tid; e < 1024; e += 512) gd[e] = bf2f(F.PROJ[(tok0 + (e >> 4)) * NPROJ + C_GD + (e & 15)]);
            __syncthreads();
            for (int e = tid; e < 4096; e += 512) { const int t = e >> 6, d = e & 63; float xg = bg[d];
#pragma unroll
                for (int r = 0; r < 16; ++r) xg += gd[t * 16 + r] * Wg[r * 64 + d];
                att[t * 65 + d] = (fminf(xg, 0.f) - log1pf(__expf(-fabsf(xg)))) * (1.0f / 16.0f); }
            __syncthreads();
            if (tid < 64) { float run = 0.f; for (int t = 0; t < 64; ++t) { run += att[t * 65 + tid]; att[t * 65 + tid] = run; } ebl[tid] = __expf(run); }
            __syncthreads();
            for (int e = tid; e < 4096; e += 512) { const int t = e >> 6, d = e & 63; const float bc = att[t * 65 + d];
                const float q = bf2f(F.PROJ[(tok0 + t) * NPROJ + C_QB + h * 64 + d]), k = bf2f(F.PROJ[(tok0 + t) * NPROJ + C_KB + h * 64 + d]);
                qin[t * 65 + d] = q * 0.125f * __expf(bc); kin[t * 65 + d] = k * __expf(-bc); }
            for (int e = tid; e < 8192; e += 512) vv[e] = bf2f(F.PROJ[(tok0 + (e >> 7)) * NPROJ + C_VB + h * 128 + (e & 127)]);
            __syncthreads();
            for (int e = tid; e < 4096; e += 512) { const int t = e >> 6, s = e & 63; float a = 0.f;
                if (s <= t) {
#pragma unroll 8
                    for (int d = 0; d < 64; ++d) a += qin[t * 65 + d] * kin[s * 65 + d]; }
                att[t * 65 + s] = a; }
            __syncthreads();
            const int v = tid & 127, q4 = tid >> 7; float o[16];
#pragma unroll
            for (int i = 0; i < 16; ++i) { const int t = q4 * 16 + i; float a = 0.f;
                for (int s = 0; s <= t; ++s) a += att[t * 65 + s] * vv[s * 128 + v];
#pragma unroll 8
                for (int d = 0; d < 64; ++d) a += qin[t * 65 + d] * S[d * 128 + v];
                o[i] = a; }
            __syncthreads();
#pragma unroll 1
            for (int i = 0; i < 16; ++i) { const int d = q4 * 16 + i; float a = 0.f;
#pragma unroll 8
                for (int s = 0; s < 64; ++s) a += kin[s * 65 + d] * vv[s * 128 + v];
                S[d * 128 + v] = ebl[d] * (S[d * 128 + v] + a); }
            __syncthreads();
#pragma unroll
            for (int i = 0; i < 16; ++i) vv[(q4 * 16 + i) * 128 + v] = o[i];
            __syncthreads();
            for (int r = 0; r < 8; ++r) { const int t = wave * 8 + r; const float x0 = vv[t * 128 + lane], x1 = vv[t * 128 + 64 + lane];
                const float rr = 1.0f / sqrtf(wave_sum(x0 * x0 + x1 * x1) * (1.0f / 128.0f) + EPS);
                const float g0 = bf2f(F.PROJ[(tok0 + t) * NPROJ + C_OG + h * 128 + lane]), g1 = bf2f(F.PROJ[(tok0 + t) * NPROJ + C_OG + h * 128 + 64 + lane]);
                const float y0 = x0 * rr * F.gla_norm[h * 128 + lane] * (g0 / (1.0f + __expf(-g0))), y1 = x1 * rr * F.gla_norm[h * 128 + 64 + lane] * (g1 / (1.0f + __expf(-g1)));
                F.MIX[(tok0 + t) * D + 512 + h * 128 + lane] = (bf16)f2bf(y0); F.MIX[(tok0 + t) * D + 512 + h * 128 + 64 + lane] = (bf16)f2bf(y1); }
            __syncthreads();
        }
    }
}

__device__ __forceinline__ void p6_final(Frame& F) {
    const int gw = blockIdx.x * NWAVES + F.wave, NGW = F.G * NWAVES, lane = F.lane;
    for (int m = gw; m < M; m += NGW) {
        const f32x4* rp = (const f32x4*)(F.RS2 + (size_t)m * 16); const f32x4 p0 = rp[0], p1 = rp[1], p2 = rp[2], p3 = rp[3];
        const float ssq = ((p0[0] + p0[1]) + (p0[2] + p0[3])) + ((p1[0] + p1[1]) + (p1[2] + p1[3])) + ((p2[0] + p2[1]) + (p2[2] + p2[3])) + ((p3[0] + p3[1]) + (p3[2] + p3[3]));
        const float r = 1.0f / sqrtf(ssq * (1.0f / D) + EPS);
        f32x4* xr = (f32x4*)(F.out + (size_t)m * D) + lane; const f32x4* gr = (const f32x4*)F.norm_final + lane;
#pragma unroll
        for (int j = 0; j < 4; ++j) { const f32x4 v = xr[64 * j], g = gr[64 * j]; xr[64 * j] = v * r * g; }
    }
}

struct Args { const float* in[13]; float* out; unsigned char* ws; int ph_lo, ph_hi; };
__global__ void __launch_bounds__(NWAVES * 64, 2) fwd(Args args) {
    extern __shared__ __attribute__((aligned(16))) unsigned char lds[];
    Frame F;
    F.lds = (LAS unsigned char*)lds;
    F.MISC = (volatile LAS unsigned*)(F.lds + MISC_OFF);
    F.tid = threadIdx.x; F.lane = F.tid & 63; F.wave = __builtin_amdgcn_readfirstlane(F.tid >> 6);
    F.G = gridDim.x;
    unsigned char* ws = args.ws;
    F.ctl = (unsigned*)(ws + WS_CTL);
    F.x = args.in[0]; F.norm_mix = args.in[1]; F.w_in = args.in[2]; F.w_gate_up = args.in[3]; F.b_gate = args.in[4]; F.gla_norm = args.in[5]; F.w_out = args.in[6]; F.rel_bias = args.in[7];
    F.norm_ffn = args.in[8]; F.w_ffn_gate = args.in[9]; F.w_ffn_up = args.in[10]; F.w_ffn_down = args.in[11]; F.norm_final = args.in[12]; F.out = args.out;
    F.WIN = (bf16*)(ws + WS_WIN); F.WOUT = (bf16*)(ws + WS_WOUT); F.WGU = (bf16*)(ws + WS_WGU); F.WDN = (bf16*)(ws + WS_WDN);
    F.H = (bf16*)(ws + WS_H); F.PROJ = (bf16*)(ws + WS_PROJ); F.MIX = (bf16*)(ws + WS_MIX); F.ACT = (bf16*)(ws + WS_PROJ);
    F.RS1 = (float*)(ws + WS_RS1); F.RS2 = (float*)(ws + WS_RS2);
    for (int u = F.tid; u < (LDS_BYTES - LDSCTL_OFF) / 4; u += NWAVES * 64) ((LAS unsigned*)(F.lds + LDSCTL_OFF))[u] = 0u;
    __syncthreads();
    XcdBarrier bar; bar.bar = F.ctl + CW_BAR; bar.x = 0; bar.st = nullptr;
    if (N_LAUNCHES == 1) bar = xcd_barrier_post(F.ctl + CW_BAR, F.MISC + 8);
    const int lo = args.ph_lo, hi = args.ph_hi;
#define IN(k) (lo <= (k) && (k) < hi)
#define SEAM(k) do { if (IN(k) && IN((k) + 1)) xcd_barrier(bar); } while (0)

    if (IN(0)) { p0_prologue(F); }
    SEAM(0);
    if (IN(1)) {
        pg8::Gemm g{F.H, F.WIN, M, NPROJ, D}; pg8::StaticOrder S; S.init(M, NPROJ, F.G, (int)blockIdx.x);
        pg8::EpiBf16<0> E{F.PROJ, NPROJ, nullptr, 0, 0, 1.f};
        pg8::gemm_phase<pg8::EpiBf16<0>, pg8::StaticOrder, true, true>(F.lds + RING_OFF, g, S, E);
    }
    SEAM(1);
    if (IN(2)) { gla_simple(F); __syncthreads(); dsa_simple(F); }
    SEAM(2);
    if (IN(3)) {
        pg8::Gemm g{F.MIX, F.WOUT, M, D, D}; pg8::StaticOrder S; S.init(M, D, F.G, (int)blockIdx.x);
        pg8::EpiOut E{F.x, F.out, F.H, F.norm_ffn, F.RS1};
        pg8::gemm_phase<pg8::EpiOut, pg8::StaticOrder, true, true>(F.lds + RING_OFF, g, S, E);
    }
    SEAM(3);
    if (IN(4)) {
        pg8::Gemm g{F.H, F.WGU, M, NGU, D}; pg8::StaticOrder S; S.init(M, NGU, F.G, (int)blockIdx.x);
        pg8::EpiGU E{F.RS1, F.ACT, EPS};
        pg8::gemm_phase<pg8::EpiGU, pg8::StaticOrder, true, true>(F.lds + RING_OFF, g, S, E);
    }
    SEAM(4);
    if (IN(5)) {
        pg8::Gemm g{F.ACT, F.WDN, M, D, FF}; pg8::StaticOrder S; S.init(M, D, F.G, (int)blockIdx.x);
        pg8::EpiDown E{F.out, F.RS2};
        pg8::gemm_phase<pg8::EpiDown, pg8::StaticOrder, true, true>(F.lds + RING_OFF, g, S, E);
    }
    SEAM(5);
    if (IN(6)) { p6_final(F); }
#undef IN
#undef SEAM
}

extern "C" void kernel_launch(void* const* d_in, const int* in_sizes, int n_in, void* d_out, int out_size, void* d_ws, size_t ws_size, hipStream_t stream) {
    static int grid = 0;
    if (grid == 0) {
        if (n_in != 13 || in_sizes[0] != M * D || out_size != M * D || ws_size < WS_END) { fprintf(stderr, "kernel_launch: unexpected shapes (n_in %d, in0 %d, out %d, ws %zu)\n", n_in, n_in > 0 ? in_sizes[0] : -1, out_size, ws_size); grid = -1; return; }
        int dev = 0, cus = 0, per_cu = 0;
        if (hipGetDevice(&dev) != hipSuccess || hipDeviceGetAttribute(&cus, hipDeviceAttributeMultiprocessorCount, dev) != hipSuccess) { grid = -1; return; }
        if (hipFuncSetAttribute((const void*)fwd, hipFuncAttributeMaxDynamicSharedMemorySize, LDS_BYTES) != hipSuccess) { fprintf(stderr, "kernel_launch: hipFuncSetAttribute failed\n"); grid = -1; return; }
        if (hipOccupancyMaxActiveBlocksPerMultiprocessor(&per_cu, (const void*)fwd, NWAVES * 64, LDS_BYTES) != hipSuccess || per_cu < 1) fprintf(stderr, "kernel_launch: occupancy query reports %d\n", per_cu);
        (void)hipGetLastError();
        grid = cus;
    }
    if (grid < 0) return;
    (void)hipMemsetAsync((char*)d_ws + WS_CTL, 0, CTL_ZERO_BYTES, stream);
    Args a{};
    for (int i = 0; i < 13; ++i) a.in[i] = (const float*)d_in[i];
    a.out = (float*)d_out; a.ws = (unsigned char*)d_ws;
    if (N_LAUNCHES == 1) { a.ph_lo = 0; a.ph_hi = N_PHASES; hipLaunchKernelGGL(fwd, dim3(grid), dim3(NWAVES * 64), LDS_BYTES, stream, a); }
    else for (int p = 0; p < N_PHASES; ++p) { a.ph_lo = p; a.ph_hi = p + 1; hipLaunchKernelGGL(fwd, dim3(grid), dim3(NWAVES * 64), LDS_BYTES, stream, a); }
}
```

```cpp
#include <hip/hip_runtime.h>
#include <cstdio>
#include <cstdint>
namespace pg8 {
#define PG8_LAS __attribute__((address_space(3)))
typedef unsigned short bf16_t;
typedef short bf16x8 __attribute__((ext_vector_type(8)));
typedef float f32x4 __attribute__((ext_vector_type(4)));
typedef unsigned u32x4 __attribute__((ext_vector_type(4)));
constexpr int BM = 256, BK = 64, HALF = 128, HTB = HALF * BK * 2  , STAGE_BYTES = 8 * HTB, NXCD = 8, WGM = 8;

__host__ __device__ __forceinline__ int lds_byte(int r, int c) { const int st = (r >> 4) * 2 + (c >> 5), rr = r & 15, cc = c & 31, ob = rr * 64 + cc * 2; return st * 1024 + (ob ^ (((ob >> 9) & 1) << 5)); }
__host__ __device__ __forceinline__ void stage_rc(int b, int& R, int& C) { const int st = b / 1024, sb = b % 1024, swz = sb ^ (((sb >> 9) & 1) << 5); R = (st >> 1) * 16 + swz / 64; C = (st & 1) * 32 + (swz % 64) / 2; }
__host__ __device__ __forceinline__ int perm32(int rho) { const int n = rho >> 4, i = rho & 15; return 8 * (i >> 2) + 4 * n + (i & 3); }

struct Unit { int pm, pn; };
struct Gemm { const bf16_t* A; const bf16_t* Bt; int M, N, K; };

struct StaticOrder {
    int nM, nN, nwg, G, c;
    __host__ __device__ void init(int M, int N, int G_, int c_) { nM = M / BM; nN = N / BM; nwg = nM * nN; G = G_; c = c_; }
    __host__ __device__ bool next(int i, Unit& u) const {
        const long L = (long)i * G + c; if (L >= nwg) return false;
        int wgid = (int)L; { const int q = nwg / NXCD, r = nwg % NXCD, xcd = wgid % NXCD, off = wgid / NXCD; wgid = (xcd < r ? xcd * (q + 1) : r * (q + 1) + (xcd - r) * q) + off; }
        const int nig = WGM * nN, gid = wgid / nig, fm = gid * WGM, gsz = (nM - fm) < WGM ? (nM - fm) : WGM;
        u.pm = fm + ((wgid % nig) % gsz); u.pn = (wgid % nig) / gsz; return true;
    }
    __device__ __forceinline__ void a_ready(const Unit&) const {}
    __device__ __forceinline__ void done(const Unit&) const {}
};

__device__ __forceinline__ unsigned cvt_pk_bf16(float lo, float hi) { unsigned r; asm volatile("v_cvt_pk_bf16_f32 %0, %1, %2" : "=v"(r) : "v"(lo), "v"(hi)); return r; }
typedef float f32x2 __attribute__((ext_vector_type(2)));
__device__ __forceinline__ f32x2 gelu_pk(f32x2 v) {
    const f32x2 av = __builtin_elementwise_abs(v), d = av * 0.2316418882f + 1.0f;
    f32x2 t; t.x = __builtin_amdgcn_rcpf(d.x); t.y = __builtin_amdgcn_rcpf(d.y);
    f32x2 q = t * 0.5307027145f + (-0.7265760135f); q = q * t + 0.7107068705f; q = q * t + (-0.142248368f); q = q * t + 0.127414796f; q = q * t;
    const f32x2 s = (v * v) * (-0.72134752044f);
    f32x2 e; e.x = __builtin_amdgcn_exp2f(s.x); e.y = __builtin_amdgcn_exp2f(s.y);
    const f32x2 m = v * (q * e), r = v - m;
    f32x2 o; o.x = v.x < 0.f ? m.x : r.x; o.y = v.y < 0.f ? m.y : r.y; return o;
}

template <int ACT  > struct EpiBf16 {
    static constexpr bool PERM = true, AFTER_DRAIN = false; static_assert(ACT == 0 || ACT == 1, "EpiBf16: ACT is 0 (none) or 1 (gelu_pk)");
    bf16_t* O; int ldc; const float* bias; int split_cols; size_t split_stride; float scale0;
    __device__ __forceinline__ void operator()(const f32x4 (&acc)[2][2][4][2], const Unit& u, int wr, int wc, int fr, int fq) const {
        const int row0 = u.pm * BM + wr * 64 + fr; int colt = u.pn * BM; bf16_t* base = O;
        float sc = 1.f; if (split_cols) { const int t = colt / split_cols; base += (size_t)t * split_stride; colt -= t * split_cols; if (t == 0) sc = scale0; }
        const int col0 = colt + wc * 32 + 8 * fq, bcol0 = u.pn * BM + wc * 32 + 8 * fq;
        f32x4 bv[2][2];
#pragma unroll
        for (int bj = 0; bj < 2; ++bj)
#pragma unroll
            for (int n = 0; n < 2; ++n) bv[bj][n] = bias ? *(const f32x4*)(bias + bcol0 + bj * HALF + 4 * n) : (f32x4){0.f, 0.f, 0.f, 0.f};
#pragma unroll
        for (int ai = 0; ai < 2; ++ai)
#pragma unroll
            for (int m = 0; m < 4; ++m) { bf16_t* rowp = base + (size_t)(row0 + ai * HALF + m * 16) * ldc + col0;
#pragma unroll
                for (int bj = 0; bj < 2; ++bj) { f32x4 v0 = acc[ai][bj][m][0] + bv[bj][0], v1 = acc[ai][bj][m][1] + bv[bj][1];
                    if (ACT == 1) { f32x2 a = gelu_pk((f32x2){v0[0], v0[1]}), b = gelu_pk((f32x2){v0[2], v0[3]}), c = gelu_pk((f32x2){v1[0], v1[1]}), d = gelu_pk((f32x2){v1[2], v1[3]});
                        v0 = (f32x4){a.x, a.y, b.x, b.y}; v1 = (f32x4){c.x, c.y, d.x, d.y}; }
                    v0 = v0 * sc; v1 = v1 * sc; u32x4 w; w.x = cvt_pk_bf16(v0[0], v0[1]); w.y = cvt_pk_bf16(v0[2], v0[3]); w.z = cvt_pk_bf16(v1[0], v1[1]); w.w = cvt_pk_bf16(v1[2], v1[3]);
                    *(u32x4*)(rowp + bj * HALF) = w; } }
    }
};
struct EpiOut {
    static constexpr bool PERM = true, AFTER_DRAIN = false;
    const float* x; float* x1; bf16_t* hn; const float* g; float* rs;
    __device__ __forceinline__ void operator()(const f32x4 (&acc)[2][2][4][2], const Unit& u, int wr, int wc, int fr, int fq) const {
        const int row0 = u.pm * BM + wr * 64 + fr, col0 = u.pn * BM + wc * 32 + 8 * fq;
        f32x4 gv[2][2];
#pragma unroll
        for (int bj = 0; bj < 2; ++bj)
#pragma unroll
            for (int n = 0; n < 2; ++n) gv[bj][n] = *(const f32x4*)(g + col0 + bj * HALF + 4 * n);
#pragma unroll
        for (int ai = 0; ai < 2; ++ai)
#pragma unroll
            for (int m = 0; m < 4; ++m) { const int row = row0 + ai * HALF + m * 16; const size_t off = (size_t)row * 1024 + col0; float ss = 0.f;
#pragma unroll
                for (int bj = 0; bj < 2; ++bj) {
                    const f32x4 xa = *(const f32x4*)(x + off + bj * HALF), xb = *(const f32x4*)(x + off + bj * HALF + 4);
                    const f32x4 v0 = acc[ai][bj][m][0] + xa, v1 = acc[ai][bj][m][1] + xb;
                    *(f32x4*)(x1 + off + bj * HALF) = v0; *(f32x4*)(x1 + off + bj * HALF + 4) = v1;
                    ss += (v0[0] * v0[0] + v0[1] * v0[1]) + (v0[2] * v0[2] + v0[3] * v0[3]) + (v1[0] * v1[0] + v1[1] * v1[1]) + (v1[2] * v1[2] + v1[3] * v1[3]);
                    const f32x4 h0 = v0 * gv[bj][0], h1 = v1 * gv[bj][1];
                    u32x4 w; w.x = cvt_pk_bf16(h0[0], h0[1]); w.y = cvt_pk_bf16(h0[2], h0[3]); w.z = cvt_pk_bf16(h1[0], h1[1]); w.w = cvt_pk_bf16(h1[2], h1[3]);
                    *(u32x4*)(hn + off + bj * HALF) = w; }
                ss += __shfl_xor(ss, 16); ss += __shfl_xor(ss, 32);
                if (fq == 0) rs[(size_t)row * 16 + u.pn * 4 + wc] = ss; }
    }
};
struct EpiGU {
    static constexpr bool PERM = true, AFTER_DRAIN = false;
    const float* rs; bf16_t* act; float eps;
    __device__ __forceinline__ void operator()(const f32x4 (&acc)[2][2][4][2], const Unit& u, int wr, int wc, int fr, int fq) const {
        const int row0 = u.pm * BM + wr * 64 + fr, col0 = u.pn * HALF + wc * 32 + 8 * fq;
#pragma unroll
        for (int ai = 0; ai < 2; ++ai)
#pragma unroll
            for (int m = 0; m < 4; ++m) { const int row = row0 + ai * HALF + m * 16;
                const f32x4* rp = (const f32x4*)(rs + (size_t)row * 16); const f32x4 p0 = rp[0], p1 = rp[1], p2 = rp[2], p3 = rp[3];
                const float ssq = ((p0[0] + p0[1]) + (p0[2] + p0[3])) + ((p1[0] + p1[1]) + (p1[2] + p1[3])) + ((p2[0] + p2[1]) + (p2[2] + p2[3])) + ((p3[0] + p3[1]) + (p3[2] + p3[3]));
                const float r = 1.0f / sqrtf(ssq * (1.0f / 1024.0f) + eps);
                float a[8];
#pragma unroll
                for (int n = 0; n < 2; ++n)
#pragma unroll
                    for (int j = 0; j < 4; ++j) { const float gg = acc[ai][0][m][n][j] * r, uu = acc[ai][1][m][n][j] * r;
                        a[4 * n + j] = gg * __builtin_amdgcn_rcpf(1.0f + __builtin_amdgcn_exp2f(gg * -1.44269504f)) * uu; }
                u32x4 w; w.x = cvt_pk_bf16(a[0], a[1]); w.y = cvt_pk_bf16(a[2], a[3]); w.z = cvt_pk_bf16(a[4], a[5]); w.w = cvt_pk_bf16(a[6], a[7]);
                *(u32x4*)(act + (size_t)row * 2816 + col0) = w; }
    }
};
struct EpiDown {
    static constexpr bool PERM = true, AFTER_DRAIN = false;
    float* xio; float* rs;
    __device__ __forceinline__ void operator()(const f32x4 (&acc)[2][2][4][2], const Unit& u, int wr, int wc, int fr, int fq) const {
        const int row0 = u.pm * BM + wr * 64 + fr, col0 = u.pn * BM + wc * 32 + 8 * fq;
#pragma unroll
        for (int ai = 0; ai < 2; ++ai)
#pragma unroll
            for (int m = 0; m < 4; ++m) { const int row = row0 + ai * HALF + m * 16; const size_t off = (size_t)row * 1024 + col0; float ss = 0.f;
#pragma unroll
                for (int bj = 0; bj < 2; ++bj) {
                    const f32x4 xa = *(const f32x4*)(xio + off + bj * HALF), xb = *(const f32x4*)(xio + off + bj * HALF + 4);
                    const f32x4 v0 = acc[ai][bj][m][0] + xa, v1 = acc[ai][bj][m][1] + xb;
                    *(f32x4*)(xio + off + bj * HALF) = v0; *(f32x4*)(xio + off + bj * HALF + 4) = v1;
                    ss += (v0[0] * v0[0] + v0[1] * v0[1]) + (v0[2] * v0[2] + v0[3] * v0[3]) + (v1[0] * v1[0] + v1[1] * v1[1]) + (v1[2] * v1[2] + v1[3] * v1[3]); }
                ss += __shfl_xor(ss, 16); ss += __shfl_xor(ss, 32);
                if (fq == 0) rs[(size_t)row * 16 + u.pn * 4 + wc] = ss; }
    }
};
struct EpiProjA {
    static constexpr bool PERM = true, AFTER_DRAIN = false;
    bf16_t* QT; bf16_t* KT; bf16_t* P2;
    __device__ __forceinline__ void operator()(const f32x4 (&acc)[2][2][4][2], const Unit& u, int wr, int wc, int fr, int fq) const {
        const int row0 = u.pm * BM + wr * 64 + fr;
        if (u.pn < 4) {
            bf16_t* dst = (u.pn < 2) ? QT : KT; const float sc = (u.pn < 2) ? 0.125f : 1.0f;
#pragma unroll
            for (int bj = 0; bj < 2; ++bj) { const int c = (u.pn & 1) * BM + bj * HALF + wc * 32 + 8 * fq, h = c >> 6, p = (c & 63) >> 3;
#pragma unroll
                for (int ai = 0; ai < 2; ++ai)
#pragma unroll
                    for (int m = 0; m < 4; ++m) { const int row = row0 + ai * HALF + m * 16, b = row >> 11, t = row & 2047;
                        const f32x4 v0 = acc[ai][bj][m][0] * sc, v1 = acc[ai][bj][m][1] * sc;
                        u32x4 w; w.x = cvt_pk_bf16(v0[0], v0[1]); w.y = cvt_pk_bf16(v0[2], v0[3]); w.z = cvt_pk_bf16(v1[0], v1[1]); w.w = cvt_pk_bf16(v1[2], v1[3]);
                        *(u32x4*)(dst + ((size_t)((b * 8 + h) * 64 + (t >> 5)) * 2048 + (p >> 1) * 512 + ((p & 1) * 32 + (t & 31)) * 8)) = w; } }
        } else {
            const int col0 = (u.pn - 4) * BM + wc * 32 + 8 * fq;
#pragma unroll
            for (int ai = 0; ai < 2; ++ai)
#pragma unroll
                for (int m = 0; m < 4; ++m) { bf16_t* rowp = P2 + (size_t)(row0 + ai * HALF + m * 16) * 2048 + col0;
#pragma unroll
                    for (int bj = 0; bj < 2; ++bj) { const f32x4 v0 = acc[ai][bj][m][0], v1 = acc[ai][bj][m][1];
                        u32x4 w; w.x = cvt_pk_bf16(v0[0], v0[1]); w.y = cvt_pk_bf16(v0[2], v0[3]); w.z = cvt_pk_bf16(v1[0], v1[1]); w.w = cvt_pk_bf16(v1[2], v1[3]);
                        *(u32x4*)(rowp + bj * HALF) = w; } }
        }
    }
};
struct EpiVT {
    static constexpr bool PERM = false, AFTER_DRAIN = false;
    bf16_t* VT;
    __device__ __forceinline__ void operator()(const f32x4 (&acc)[2][2][4][2], const Unit& u, int wr, int wc, int fr, int fq) const {
#pragma unroll
        for (int bj = 0; bj < 2; ++bj)
#pragma unroll
            for (int n = 0; n < 2; ++n) { const int c = u.pn * BM + bj * HALF + wc * 32 + 16 * n + fr, h = c >> 6, d = c & 63;
#pragma unroll
                for (int ai = 0; ai < 2; ++ai)
#pragma unroll
                    for (int m = 0; m < 4; ++m) { const int row = u.pm * BM + ai * HALF + wr * 64 + m * 16 + 4 * fq, b = row >> 11, t = row & 2047;
                        const f32x4 v = acc[ai][bj][m][n];
                        unsigned lo = cvt_pk_bf16(v[0], v[1]), hi = cvt_pk_bf16(v[2], v[3]);
                        typedef unsigned u32x2 __attribute__((ext_vector_type(2)));
                        u32x2 w; w.x = lo; w.y = hi;
                        *(u32x2*)(VT + ((size_t)((b * 8 + h) * 64 + (t >> 5)) * 2048 + (d >> 5) * 1024 + ((t >> 4) & 1) * 512 + ((((t >> 2) & 1) * 32) + (d & 31)) * 8 + 4 * ((t >> 3) & 1))) = w; } }
    }
};
template <class Epi, class Sched, bool ALIGN_EPI = false, bool SP2 = false, bool SWAP = false>
__device__ __forceinline__ void gemm_phase(PG8_LAS unsigned char* lds, const Gemm g, const Sched& S, const Epi& E) {
    const int tid = threadIdx.x, wid = __builtin_amdgcn_readfirstlane(tid >> 6), lane = tid & 63, wr = wid >> 2, wc = wid & 3, fr = lane & 15, fq = lane >> 4;
    const int K = g.K, nt = K / BK;
    unsigned voffA[2], voffB[2];
#pragma unroll
    for (int i = 0; i < 2; ++i) { int R, C; stage_rc(tid * 16 + i * 8192, R, C); const int Rb = Epi::PERM ? ((R & ~31) + perm32(R & 31)) : R;
        voffA[i] = (unsigned)(R * K + C) * 2u; voffB[i] = (unsigned)(Rb * K + C) * 2u; }
    const size_t kstep = (size_t)(BK * 2);
    const size_t hstep = (size_t)HALF * K * 2;
    const size_t tstep = 2 * hstep;
    const unsigned ldsw = (unsigned)wid * 1024u;
    const int aoff = lds_byte(wr * 64 + fr, fq * 8), boff = lds_byte(wc * 32 + fr, fq * 8);
#define PG8_SA(b, h) (((b) * 2 + (h)) * HTB)
#define PG8_SB(b, h) ((4 + (b) * 2 + (h)) * HTB)
#define PG8_STAGE(bufoff, gbase, voff) do { _Pragma("unroll") for (int _i = 0; _i < 2; ++_i) \
        __builtin_amdgcn_global_load_lds((const unsigned*)((const char*)(gbase) + (voff)[_i]), (PG8_LAS unsigned*)(lds + (bufoff) + ldsw + _i * 8192), 16, 0, 0); } while (0)
#define PG8_LDA(dst, b, h) do { _Pragma("unroll") for (int m = 0; m < 4; ++m) _Pragma("unroll") for (int k = 0; k < 2; ++k) dst[m][k] = *(const PG8_LAS bf16x8*)(lds + PG8_SA(b, h) + aoff + m * 2048 + k * 1024); } while (0)
#define PG8_LDB(dst, b, h) do { _Pragma("unroll") for (int n = 0; n < 2; ++n) _Pragma("unroll") for (int k = 0; k < 2; ++k) dst[n][k] = *(const PG8_LAS bf16x8*)(lds + PG8_SB(b, h) + boff + n * 2048 + k * 1024); } while (0)
#define PG8_MMA(ai, bj, At, Bt) do { __builtin_amdgcn_s_setprio(1); _Pragma("unroll") for (int m = 0; m < 4; ++m) _Pragma("unroll") for (int n = 0; n < 2; ++n) _Pragma("unroll") for (int k = 0; k < 2; ++k) \
        { if constexpr (SWAP) acc[ai][bj][m][n] = __builtin_amdgcn_mfma_f32_16x16x32_bf16(At[m][k], Bt[n][k], acc[ai][bj][m][n], 0, 0, 0); else acc[ai][bj][m][n] = __builtin_amdgcn_mfma_f32_16x16x32_bf16(Bt[n][k], At[m][k], acc[ai][bj][m][n], 0, 0, 0); } __builtin_amdgcn_s_setprio(0); } while (0)
#define PG8_WAIT_V(n) asm volatile("s_waitcnt vmcnt(" #n ")" ::: "memory")
#define PG8_WAIT_L(n) asm volatile("s_waitcnt lgkmcnt(" #n ")" ::: "memory")
#define PG8_BAR __builtin_amdgcn_s_barrier()
#define PG8_SCHED __builtin_amdgcn_sched_barrier(0)
    Unit cur, nxt; int ui = 0;
    if (!S.next(0, cur)) return;
    f32x4 acc[2][2][4][2];
#pragma unroll
    for (int a = 0; a < 2; ++a)
#pragma unroll
        for (int b = 0; b < 2; ++b)
#pragma unroll
            for (int m = 0; m < 4; ++m)
#pragma unroll
                for (int n = 0; n < 2; ++n) acc[a][b][m][n] = (f32x4){0.f, 0.f, 0.f, 0.f};
    bf16x8 At[4][2], B0[2][2], B1[2][2];
    const char* cA = (const char*)g.A + (size_t)cur.pm * tstep; const char* cB = (const char*)g.Bt + (size_t)cur.pn * tstep;
    S.a_ready(cur);
    if constexpr (SP2) {
        PG8_STAGE(PG8_SB(0, 0), cB, voffB); PG8_STAGE(PG8_SB(0, 1), cB + hstep, voffB); PG8_STAGE(PG8_SA(0, 0), cA, voffA); PG8_STAGE(PG8_SA(0, 1), cA + hstep, voffA);
        if (wr == 1) PG8_BAR;
        PG8_WAIT_V(2); PG8_BAR;
        PG8_STAGE(PG8_SB(1, 0), cB + kstep, voffB); PG8_STAGE(PG8_SA(1, 0), cA + kstep, voffA); PG8_STAGE(PG8_SB(1, 1), cB + hstep + kstep, voffB);
        PG8_WAIT_V(6); PG8_BAR;
    } else {
        PG8_STAGE(PG8_SB(0, 0), cB, voffB); PG8_STAGE(PG8_SA(0, 0), cA, voffA); PG8_STAGE(PG8_SB(0, 1), cB + hstep, voffB); PG8_STAGE(PG8_SA(0, 1), cA + hstep, voffA);
        if (wr == 1) PG8_BAR;
        PG8_WAIT_V(4); PG8_BAR;
        PG8_STAGE(PG8_SB(1, 0), cB + kstep, voffB); PG8_STAGE(PG8_SA(1, 0), cA + kstep, voffA); PG8_STAGE(PG8_SB(1, 1), cB + hstep + kstep, voffB);
        PG8_WAIT_V(6); PG8_BAR;
    }
    for (;;) {
        const bool has_next = S.next(ui + 1, nxt);
        const char* nA = has_next ? (const char*)g.A + (size_t)nxt.pm * tstep : cA; const char* nB = has_next ? (const char*)g.Bt + (size_t)nxt.pn * tstep : cB;
        for (int t = 0; t < nt; t += 2) {
            const bool last = (t == nt - 2);
            const char* a1 = cA + (size_t)(t + 1) * kstep;
            const char* a2 = last ? nA : cA + (size_t)(t + 2) * kstep; const char* b2 = last ? nB : cB + (size_t)(t + 2) * kstep;
            const char* a3 = a2 + kstep; const char* b3 = b2 + kstep;
            if (last && has_next) S.a_ready(nxt);
            if constexpr (SP2) {
            PG8_LDB(B0, 0, 0); PG8_LDB(B1, 0, 1); PG8_SCHED; PG8_LDA(At, 0, 0); PG8_STAGE(PG8_SA(1, 1), a1 + hstep, voffA);
            PG8_WAIT_V(8); PG8_WAIT_L(0); PG8_BAR; PG8_MMA(0, 0, At, B0); PG8_MMA(0, 1, At, B1); PG8_BAR; PG8_SCHED;
            PG8_LDA(At, 0, 1); PG8_STAGE(PG8_SB(0, 0), b2, voffB); PG8_STAGE(PG8_SB(0, 1), b2 + hstep, voffB); PG8_STAGE(PG8_SA(0, 0), a2, voffA);
            PG8_WAIT_V(8); PG8_WAIT_L(0); PG8_BAR; PG8_MMA(1, 0, At, B0); PG8_MMA(1, 1, At, B1); PG8_BAR; PG8_SCHED;
            PG8_LDB(B0, 1, 0); PG8_LDB(B1, 1, 1); PG8_SCHED; PG8_LDA(At, 1, 0); PG8_STAGE(PG8_SA(0, 1), a2 + hstep, voffA);
            PG8_WAIT_V(8); PG8_WAIT_L(0); PG8_BAR; PG8_MMA(0, 0, At, B0); PG8_MMA(0, 1, At, B1); PG8_BAR; PG8_SCHED;
            PG8_LDA(At, 1, 1); PG8_STAGE(PG8_SB(1, 0), b3, voffB); PG8_STAGE(PG8_SB(1, 1), b3 + hstep, voffB); PG8_STAGE(PG8_SA(1, 0), a3, voffA);
            PG8_WAIT_V(8); PG8_WAIT_L(0); PG8_BAR; PG8_MMA(1, 0, At, B0); PG8_MMA(1, 1, At, B1); PG8_BAR; PG8_SCHED;
            } else {
            PG8_LDB(B0, 0, 0); PG8_SCHED; PG8_LDA(At, 0, 0); PG8_STAGE(PG8_SA(1, 1), a1 + hstep, voffA);
            PG8_WAIT_L(8); PG8_BAR; PG8_WAIT_L(0); PG8_MMA(0, 0, At, B0); PG8_BAR; PG8_SCHED;
            PG8_LDB(B1, 0, 1); PG8_STAGE(PG8_SB(0, 0), b2, voffB);
            PG8_BAR; PG8_WAIT_L(0); PG8_MMA(0, 1, At, B1); PG8_BAR;
            PG8_LDA(At, 0, 1); PG8_STAGE(PG8_SA(0, 0), a2, voffA);
            PG8_BAR; PG8_WAIT_L(0); PG8_MMA(1, 0, At, B0); PG8_BAR; PG8_SCHED;
            PG8_STAGE(PG8_SB(0, 1), b2 + hstep, voffB);
            PG8_WAIT_V(6); PG8_BAR; PG8_MMA(1, 1, At, B1); PG8_BAR;
            PG8_LDB(B0, 1, 0); PG8_SCHED; PG8_LDA(At, 1, 0); PG8_STAGE(PG8_SA(0, 1), a2 + hstep, voffA);
            PG8_WAIT_L(8); PG8_BAR; PG8_WAIT_L(0); PG8_MMA(0, 0, At, B0); PG8_BAR; PG8_SCHED;
            PG8_LDB(B1, 1, 1); PG8_STAGE(PG8_SB(1, 0), b3, voffB);
            PG8_BAR; PG8_WAIT_L(0); PG8_MMA(0, 1, At, B1); PG8_BAR;
            PG8_LDA(At, 1, 1); PG8_STAGE(PG8_SA(1, 0), a3, voffA);
            PG8_BAR; PG8_WAIT_L(0); PG8_MMA(1, 0, At, B0); PG8_BAR; PG8_SCHED;
            PG8_STAGE(PG8_SB(1, 1), b3 + hstep, voffB);
            PG8_WAIT_V(6); PG8_BAR; PG8_MMA(1, 1, At, B1); PG8_BAR;
            }
        }
        if constexpr (ALIGN_EPI) { if (wr == 0) PG8_BAR; }
        if constexpr (!Epi::AFTER_DRAIN) { E(acc, cur, wr, wc, fr, fq); S.done(cur); }
        if (!has_next) break;
#pragma unroll
        for (int a = 0; a < 2; ++a)
#pragma unroll
            for (int b = 0; b < 2; ++b)
#pragma unroll
                for (int m = 0; m < 4; ++m)
#pragma unroll
                    for (int n = 0; n < 2; ++n) acc[a][b][m][n] = (f32x4){0.f, 0.f, 0.f, 0.f};
        cur = nxt; cA = nA; cB = nB; ++ui;
        if constexpr (ALIGN_EPI) { if (wr == 1) PG8_BAR; }
    }
    PG8_WAIT_V(0);
    if constexpr (!ALIGN_EPI) { if (wr == 0) PG8_BAR; }
    PG8_BAR;
    if constexpr (Epi::AFTER_DRAIN) { E.fused(acc, cur, wr, wc, fr, fq, lds, wid, lane); S.done(cur); }
#undef PG8_SA
#undef PG8_SB
#undef PG8_STAGE
#undef PG8_LDA
#undef PG8_LDB
#undef PG8_MMA
#undef PG8_WAIT_V
#undef PG8_WAIT_L
#undef PG8_BAR
#undef PG8_SCHED
}
}
#define LAS __attribute__((address_space(3)))
#define XB_TMO      128
#define XB_XCNT(j)  (256  + 64 * (j))
#define XB_XSUB(j)  (1280 + 64 * (j))
#define XB_XGEN(j)  (2304 + 64 * (j))
#define XB_TOP      3328
#define XB_TOPGEN   3392
#define XCD_BAR_WORDS 3456
#define XB_SPIN_CAP (1u << 18)

__device__ __forceinline__ unsigned xb_ld(unsigned* p)              { return __hip_atomic_load(p, __ATOMIC_RELAXED, __HIP_MEMORY_SCOPE_AGENT); }
__device__ __forceinline__ unsigned xb_add(unsigned* p, unsigned v) { return __hip_atomic_fetch_add(p, v, __ATOMIC_RELAXED, __HIP_MEMORY_SCOPE_AGENT); }
__device__ __forceinline__ unsigned xb_xcc_id() { return (unsigned)__builtin_amdgcn_s_getreg((3 << 11) | 20) & 0xFu; }
#define XB_SPIN(cond, bar) do { unsigned _sp = 0; while (cond) { __builtin_amdgcn_s_sleep(1); \
    if ((++_sp & 255u) == 0u) { if (xb_ld(&(bar)[XB_TMO])) break; if (_sp > XB_SPIN_CAP) { atomicAdd(&(bar)[XB_TMO], 1u); break; } } } } while (0)

struct XcdBarrier {
    unsigned* bar; unsigned x;
    volatile LAS unsigned* st;
};

__device__ __forceinline__ XcdBarrier xcd_barrier_post(unsigned* bar, volatile LAS unsigned* st) {
    XcdBarrier b; b.bar = bar; b.x = xb_xcc_id(); b.st = st;
    if (threadIdx.x == 0) (void)xb_add(&bar[XB_XCNT(b.x)], 1u);
    return b;
}
__device__ __forceinline__ void xcd_barrier_complete(unsigned* bar, unsigned x, unsigned& nloc, unsigned& nx) {
    const unsigned G = gridDim.x * gridDim.y * gridDim.z;
    unsigned sum, cnt, mine, sp = 0u;
    for (;;) {
        sum = 0u; cnt = 0u; mine = 0u;
#pragma unroll
        for (unsigned j = 0; j < 16; ++j) { const unsigned c = xb_ld(&bar[XB_XCNT(j)]); sum += c; cnt += (c > 0u) ? 1u : 0u; mine = (j == x) ? c : mine; }
        if (sum == G) break;
        __builtin_amdgcn_s_sleep(1);
        if ((++sp & 255u) == 0u) { if (xb_ld(&bar[XB_TMO])) break; if (sp > XB_SPIN_CAP) { atomicAdd(&bar[XB_TMO], 1u); break; } }
    }
    nloc = mine > 0u ? mine : 1u; nx = cnt > 0u ? cnt : 1u;
}

__device__ __forceinline__ void xcd_barrier(const XcdBarrier& b) {
    asm volatile("s_waitcnt vmcnt(0)" ::: "memory");
    __syncthreads();
    if (threadIdx.x == 0) {
        unsigned* bar = b.bar;
        __builtin_amdgcn_s_waitcnt(0);
        unsigned nloc = b.st[0], nx = b.st[1];
        if (nloc == 0u) { xcd_barrier_complete(bar, b.x, nloc, nx); b.st[0] = nloc; b.st[1] = nx; }
        const unsigned old = xb_add(&bar[XB_XSUB(b.x)], 1u);
        const unsigned gen = old / nloc;
        if (old + 1u == (gen + 1u) * nloc) {
            __builtin_amdgcn_fence(__ATOMIC_RELEASE, "agent");
            asm volatile("s_waitcnt vmcnt(0)" ::: "memory");
            const unsigned og = xb_add(&bar[XB_TOP], 1u);
            const unsigned tg = og / nx;
            if (og + 1u == (tg + 1u) * nx) xb_add(&bar[XB_TOPGEN], 1u);
            else XB_SPIN(xb_ld(&bar[XB_TOPGEN]) == tg, bar);
            __builtin_amdgcn_fence(__ATOMIC_ACQUIRE, "agent");
            xb_add(&bar[XB_XGEN(b.x)], 1u);
            asm volatile("s_waitcnt vmcnt(0)" ::: "memory");
        } else {
            XB_SPIN(xb_ld(&bar[XB_XGEN(b.x)]) == gen, bar);
            __builtin_amdgcn_fence(__ATOMIC_ACQUIRE, "agent");
            asm volatile("s_waitcnt vmcnt(0)" ::: "memory");
        }
    }
    __syncthreads();
}
constexpr int NWAVES = 8;
#ifndef MK_N_LAUNCHES
#define MK_N_LAUNCHES 1
#endif
constexpr int N_PHASES = 7;
constexpr int N_LAUNCHES = MK_N_LAUNCHES;

constexpr int BATCH = 16, SEQ = 2048, D = 1024, M = BATCH * SEQ;
constexpr int CHUNK = 64, NCHUNK = SEQ / CHUNK;
constexpr int D_IN = 3384, NPROJ = 3584;
constexpr int FF = 2816, NGU = 2 * FF;
constexpr float EPS = 1e-6f;
constexpr int NP2 = 2048;
constexpr int C_QI = 0, C_QB = 256, C_KB = 512, C_VB = 768, C_OG = 1280, C_KI = 1792, C_WI = 1824, C_GD = 1832;
__host__ __device__ __forceinline__ int in_src(int r) {
    if (r < 1024) return r;
    if (r < 1280) return 1536 + (r - 1024);
    if (r < 1536) return 1832 + (r - 1280);
    if (r < 1792) return 2088 + (r - 1536);
    if (r < 2304) return 2344 + (r - 1792);
    if (r < 2816) return 2872 + (r - 2304);
    if (r < 2848) return 1792 + (r - 2816);
    if (r < 2856) return 1824 + (r - 2848);
    if (r < 2872) return 2856 + (r - 2856);
    if (r < 3072) return -1;
    return 1024 + (r - 3072);
}
__host__ __device__ __forceinline__ size_t qk_idx(int b, int h, int t, int d) { return (size_t)((b * 8 + h) * 64 + (t >> 5)) * 2048 + (d >> 4) * 512 + (((d >> 3) & 1) * 32 + (t & 31)) * 8 + (d & 7); }
__host__ __device__ __forceinline__ size_t vt_idx(int b, int h, int t, int d) { return (size_t)((b * 8 + h) * 64 + (t >> 5)) * 2048 + (d >> 5) * 1024 + ((t >> 4) & 1) * 512 + (((t >> 2) & 1) * 32 + (d & 31)) * 8 + 4 * ((t >> 3) & 1) + (t & 3); }

constexpr size_t MiB = 1u << 20;
constexpr size_t WS_CTL = 0, CTL_ZERO_BYTES = 1 * MiB;
constexpr size_t WS_WIN = 2 * MiB;
constexpr size_t WS_WOUT = 9 * MiB;
constexpr size_t WS_WGU = 11 * MiB;
constexpr size_t WS_WDN = 22 * MiB;
constexpr size_t WS_RS1 = 28 * MiB;
constexpr size_t WS_RS2 = 30 * MiB;
constexpr size_t WS_H = 40 * MiB;
constexpr size_t WS_QT = 104 * MiB, WS_KT = 136 * MiB, WS_VT = 168 * MiB;
constexpr size_t WS_P2 = 200 * MiB;
constexpr size_t WS_ACT = 104 * MiB;
constexpr size_t WS_MIX = 328 * MiB;
constexpr size_t WS_END = 392 * MiB;
constexpr int CW_BAR = 4096;
constexpr int CW_QUEUE = 64;

constexpr int RING_OFF = 0, RING_BYTES = 131072;
constexpr int BM_OFF = RING_BYTES;
constexpr int TB_OFF = BM_OFF + 64 * 33 * 8;
constexpr int LDSCTL_OFF = TB_OFF + 8192, MISC_OFF = LDSCTL_OFF + 320;
constexpr int LDS_BYTES = LDSCTL_OFF + 1536;
static_assert(LDS_BYTES <= 160 * 1024, "LDS map");

#define GAS __attribute__((address_space(1)))
#ifndef LAS
#define LAS __attribute__((address_space(3)))
#endif
typedef unsigned short bf16;
typedef unsigned v4u __attribute__((ext_vector_type(4)));
typedef unsigned v2u __attribute__((ext_vector_type(2)));
typedef float f32x4 __attribute__((ext_vector_type(4)));
#define LDS_WAIT() asm volatile("s_waitcnt lgkmcnt(0)" ::: "memory")
#define VM_WAIT() asm volatile("s_waitcnt vmcnt(0)" ::: "memory")
__device__ __forceinline__ unsigned f2bf(float f) { unsigned u = __builtin_bit_cast(unsigned, f); return (u + 0x7fffu + ((u >> 16) & 1u)) >> 16; }
__device__ __forceinline__ unsigned pk2(float lo, float hi) { return f2bf(lo) | (f2bf(hi) << 16); }
__device__ __forceinline__ float bf2f(unsigned short b) { return __builtin_bit_cast(float, (unsigned)b << 16); }
__device__ __forceinline__ float bflo(unsigned w) { return __builtin_bit_cast(float, w << 16); }
__device__ __forceinline__ float bfhi(unsigned w) { return __builtin_bit_cast(float, w & 0xffff0000u); }

struct Frame {
    LAS unsigned char* lds;
    volatile LAS unsigned* MISC;
    unsigned* ctl;
    int tid, lane, wave, G;
    const float *x, *norm_mix, *w_in, *w_gate_up, *b_gate, *gla_norm, *w_out, *rel_bias, *norm_ffn, *w_ffn_gate, *w_ffn_up, *w_ffn_down, *norm_final;
    float* out;
    bf16 *WIN, *WOUT, *WGU, *WDN, *H, *QT, *KT, *VT, *P2, *MIX, *ACT;
    float *RS1, *RS2;
};

__device__ __forceinline__ float wave_sum(float v) {
#pragma unroll
    for (int o = 1; o < 64; o <<= 1) v += __shfl_xor(v, o);
    return v;
}
__device__ __forceinline__ float wave_max(float v) {
#pragma unroll
    for (int o = 1; o < 64; o <<= 1) v = fmaxf(v, __shfl_xor(v, o));
    return v;
}
__device__ __forceinline__ int wave_sum_i(int v) {
#pragma unroll
    for (int o = 1; o < 64; o <<= 1) v += __shfl_xor(v, o);
    return v;
}

__device__ __forceinline__ void p0_item(const float* cp, int ld, bf16* WT, int K, int r0, int k0, LAS float* scr, int lane) {
#pragma unroll 8
    for (int i = 0; i < 32; ++i) { const int kk = 2 * i + (lane >> 5); scr[kk * 33 + (lane & 31)] = cp ? cp[(size_t)(k0 + kk) * ld] : 0.f; }
    LDS_WAIT(); asm volatile("" ::: "memory");
    const int c = lane & 7;
#pragma unroll
    for (int j = 0; j < 4; ++j) { const int n = (lane >> 3) + 8 * j; const LAS float* s = scr + (8 * c) * 33 + n;
        v4u o; o.x = pk2(s[0 * 33], s[1 * 33]); o.y = pk2(s[2 * 33], s[3 * 33]); o.z = pk2(s[4 * 33], s[5 * 33]); o.w = pk2(s[6 * 33], s[7 * 33]);
        *(v4u*)(WT + (size_t)(r0 + n) * K + k0 + 8 * c) = o; }
    LDS_WAIT(); asm volatile("" ::: "memory");
}
__device__ __forceinline__ void p0_prologue(Frame& F) {
    LAS float* scr = (LAS float*)(F.lds + RING_OFF + F.wave * 16384);
    const int gw = blockIdx.x * NWAVES + F.wave, NGW = F.G * NWAVES, lane = F.lane;
    constexpr int I_IN = (D / 64) * (NPROJ / 32), I_OUT = (D / 64) * (D / 32), I_GU = (D / 64) * (NGU / 32), I_DN = (FF / 64) * (D / 32);
    constexpr int NITEMS = I_IN + I_OUT + I_GU + I_DN;
    for (int it = gw; it < NITEMS; it += NGW) {
        int r = it;
        if (r < I_IN) { const int kb = r / (NPROJ / 32), nb = r % (NPROJ / 32); const int sc = in_src(32 * nb + (lane & 31));
            p0_item(sc >= 0 ? F.w_in + sc : nullptr, D_IN, F.WIN, D, 32 * nb, 64 * kb, scr, lane); continue; }
        r -= I_IN;
        if (r < I_OUT) { const int kb = r / (D / 32), nb = r % (D / 32);
            p0_item(F.w_out + 32 * nb + (lane & 31), D, F.WOUT, D, 32 * nb, 64 * kb, scr, lane); continue; }
        r -= I_OUT;
        if (r < I_GU) { const int kb = r / (NGU / 32), nb = r % (NGU / 32); const int rr = 32 * nb + (lane & 31), t = rr >> 8, j = rr & 255;
            const float* cp = (j < 128) ? F.w_ffn_gate + 128 * t + j : F.w_ffn_up + 128 * t + (j - 128);
            p0_item(cp, FF, F.WGU, D, 32 * nb, 64 * kb, scr, lane); continue; }
        r -= I_GU;
        { const int kb = r / (D / 32), nb = r % (D / 32);
            p0_item(F.w_ffn_down + 32 * nb + (lane & 31), D, F.WDN, FF, 32 * nb, 64 * kb, scr, lane); }
    }
    for (int m = gw; m < M; m += NGW) {
        const f32x4* xr = (const f32x4*)(F.x + (size_t)m * D) + lane; const f32x4* gr = (const f32x4*)F.norm_mix + lane;
        f32x4 v[4]; float s = 0.f;
#pragma unroll
        for (int j = 0; j < 4; ++j) { v[j] = xr[64 * j]; s += (v[j].x * v[j].x + v[j].y * v[j].y) + (v[j].z * v[j].z + v[j].w * v[j].w); }
        const float r = 1.0f / sqrtf(wave_sum(s) * (1.0f / D) + EPS);
        v2u* o8 = (v2u*)(F.H + (size_t)m * D) + lane;
#pragma unroll
        for (int j = 0; j < 4; ++j) { const f32x4 g = gr[64 * j]; v2u w; w.x = pk2(v[j].x * r * g.x, v[j].y * r * g.y); w.y = pk2(v[j].z * r * g.z, v[j].w * r * g.w); o8[64 * j] = w; }
    }
}

__device__ __forceinline__ int t5_bucket(int rel) {
    const int ret = rel > 0 ? 16 : 0; const int n = rel < 0 ? -rel : rel;
    const int v = n < 8 ? n : n < 12 ? 8 : n < 16 ? 9 : n < 23 ? 10 : n < 32 ? 11 : n < 46 ? 12 : n < 64 ? 13 : n < 91 ? 14 : 15;
    return ret + v;
}
__device__ __forceinline__ unsigned ord_key(float s) { const unsigned b = __builtin_bit_cast(unsigned, s + 0.0f); return (b & 0x80000000u) ? ~b : (b | 0x80000000u); }

__device__ __forceinline__ void dsa_simple(Frame& F) {
    LAS unsigned char* wl = F.lds + RING_OFF + F.wave * 16384;
    LAS float* sc = (LAS float*)wl;
    LAS float* qs = (LAS float*)(wl + 8192);
    LAS float* wq = (LAS float*)(wl + 9216);
    LAS unsigned* list = (LAS unsigned*)(wl + 9472);
    LAS float* pl = (LAS float*)(wl + 10496);
    LAS float* qh = (LAS float*)(wl + 11520);
    const int lane = F.lane, gw = blockIdx.x * NWAVES + F.wave, NGW = F.G * NWAVES;
    const unsigned long long lt = (1ull << lane) - 1ull;
    for (int w = gw; w < M; w += NGW) {
        const int b = w / SEQ, t = ((w % SEQ) + 131 * b) % SEQ, n = t >> 6, L = (n + 1) * CHUNK, nj = n + 1;
        const size_t m = (size_t)b * SEQ + t;
        const bf16* prow = F.P2 + m * NP2;
        { const v2u qv = *(const v2u*)(prow + C_QI + 4 * lane); qs[4 * lane] = bflo(qv.x); qs[4 * lane + 1] = bfhi(qv.x); qs[4 * lane + 2] = bflo(qv.y); qs[4 * lane + 3] = bfhi(qv.y);
          if (lane < 8) wq[lane] = bf2f(prow[C_WI + lane]) * 0.0625f; }
        LDS_WAIT(); asm volatile("" ::: "memory");
        for (int j = 0; j < nj; ++j) {
            const int key = j * 64 + lane; const v4u* kp = (const v4u*)(F.P2 + ((size_t)b * SEQ + key) * NP2 + C_KI);
            float ki[32];
#pragma unroll
            for (int q = 0; q < 4; ++q) { const v4u kv = kp[q]; ki[8 * q] = bflo(kv.x); ki[8 * q + 1] = bfhi(kv.x); ki[8 * q + 2] = bflo(kv.y); ki[8 * q + 3] = bfhi(kv.y);
                ki[8 * q + 4] = bflo(kv.z); ki[8 * q + 5] = bfhi(kv.z); ki[8 * q + 6] = bflo(kv.w); ki[8 * q + 7] = bfhi(kv.w); }
            float s = 0.f;
#pragma unroll 1
            for (int h = 0; h < 8; ++h) { float d = 0.f;
#pragma unroll
                for (int dd = 0; dd < 32; ++dd) d += qs[h * 32 + dd] * ki[dd];
                s += wq[h] * fmaxf(d, 0.f); }
            sc[key] = s;
        }
        LDS_WAIT(); asm volatile("" ::: "memory");
        unsigned selbits = 0u;
        if (L <= 256) selbits = (1u << nj) - 1u;
        else {
            unsigned u[32];
#pragma unroll
            for (int j = 0; j < 32; ++j) u[j] = (j < nj) ? ord_key(sc[j * 64 + lane]) : 0u;
            unsigned T = 0u;
            for (int bit = 31; bit >= 0; --bit) { const unsigned cand = T | (1u << bit); int c = 0;
#pragma unroll
                for (int j = 0; j < 32; ++j) c += (u[j] >= cand) ? 1 : 0;
                c = wave_sum_i(c); if (c >= 256) T = cand; }
            int cg = 0;
#pragma unroll
            for (int j = 0; j < 32; ++j) cg += (u[j] > T) ? 1 : 0;
            cg = wave_sum_i(cg); const int r = 256 - cg; int run = 0;
#pragma unroll
            for (int j = 0; j < 32; ++j) { const bool eq = (u[j] == T); const unsigned long long em = __ballot(eq); const int pre = run + __popcll(em & lt);
                if ((u[j] > T) || (eq && pre < r)) selbits |= (1u << j); run += __popcll(em); }
        }
        int nsel = 0;
#pragma unroll
        for (int j = 0; j < 32; ++j) { const bool s = (selbits >> j) & 1u; const unsigned long long mk = __ballot(s); if (s) list[nsel + __popcll(mk & lt)] = (unsigned)(j * 64 + lane); nsel += __popcll(mk); }
        LDS_WAIT(); asm volatile("" ::: "memory");
        for (int h = 0; h < 8; ++h) {
            qh[lane] = bf2f(F.QT[qk_idx(b, h, t, lane)]);
            LDS_WAIT(); asm volatile("" ::: "memory");
            float lg[4]; float mx = -1e30f;
#pragma unroll
            for (int c = 0; c < 4; ++c) { const int idx = c * 64 + lane; lg[c] = -1e30f;
                if (idx < nsel) { const int key = (int)list[idx]; float d = 0.f;
#pragma unroll
                    for (int q = 0; q < 8; ++q) { const v4u kv = *(const v4u*)(F.KT + qk_idx(b, h, key, 8 * q)); d += qh[8 * q] * bflo(kv.x) + qh[8 * q + 1] * bfhi(kv.x) + qh[8 * q + 2] * bflo(kv.y) + qh[8 * q + 3] * bfhi(kv.y)
                        + qh[8 * q + 4] * bflo(kv.z) + qh[8 * q + 5] * bfhi(kv.z) + qh[8 * q + 6] * bflo(kv.w) + qh[8 * q + 7] * bfhi(kv.w); }
                    lg[c] = d + F.rel_bias[t5_bucket(key - t) * 8 + h]; }
                mx = fmaxf(mx, lg[c]); }
            mx = wave_max(mx); float sum = 0.f;
#pragma unroll
            for (int c = 0; c < 4; ++c) { const int idx = c * 64 + lane; lg[c] = (idx < nsel) ? __expf(lg[c] - mx) : 0.f; sum += lg[c]; }
            sum = wave_sum(sum); const float inv = 1.0f / sum;
#pragma unroll
            for (int c = 0; c < 4; ++c) pl[c * 64 + lane] = lg[c] * inv;
            LDS_WAIT(); asm volatile("" ::: "memory");
            float o = 0.f;
            for (int i = 0; i < nsel; ++i) { const int key = (int)list[i]; o += pl[i] * bf2f(F.VT[vt_idx(b, h, key, lane)]); }
            F.MIX[m * D + h * 64 + lane] = (bf16)f2bf(o);
            LDS_WAIT(); asm volatile("" ::: "memory");
        }
    }
}


typedef short bf16x8 __attribute__((ext_vector_type(8)));
typedef float f32x16 __attribute__((ext_vector_type(16)));
__device__ __forceinline__ bf16x8 pack8(float a0, float a1, float a2, float a3, float a4, float a5, float a6, float a7) {
    typedef __bf16 b2 __attribute__((ext_vector_type(2))); typedef float f2 __attribute__((ext_vector_type(2)));
    v4u r;
    r.x = __builtin_bit_cast(unsigned, __builtin_convertvector((f2){a0, a1}, b2)); r.y = __builtin_bit_cast(unsigned, __builtin_convertvector((f2){a2, a3}, b2));
    r.z = __builtin_bit_cast(unsigned, __builtin_convertvector((f2){a4, a5}, b2)); r.w = __builtin_bit_cast(unsigned, __builtin_convertvector((f2){a6, a7}, b2));
    return __builtin_bit_cast(bf16x8, r);
}
__device__ __forceinline__ void dsa_bias_table(Frame& F) {
    LAS float* tb = (LAS float*)(F.lds + TB_OFF);
    for (int e = F.tid; e < 2048; e += NWAVES * 64) { const int h = e >> 8, i = e & 255; tb[e] = (i < 255) ? F.rel_bias[t5_bucket(i - 191) * 8 + h] - F.rel_bias[15 * 8 + h] : 0.f; }
}
#define DSA_FOR_J(...) do { _Pragma("unroll") for (int j = 0; j < 8; ++j) { __VA_ARGS__ } \
    if (nk > 8) { _Pragma("unroll") for (int j = 8; j < 16; ++j) { __VA_ARGS__ } } \
    if (nk > 16) { _Pragma("unroll") for (int j = 16; j < 24; ++j) { __VA_ARGS__ } } \
    if (nk > 24) { _Pragma("unroll") for (int j = 24; j < 32; ++j) { __VA_ARGS__ } } } while (0)
__device__ __forceinline__ void dsa_select(Frame& F, int b, int n) {
    const int lane = F.lane, wave = F.wave, tid = F.tid, L = (n + 1) * CHUNK, nk = n + 1;
    LAS float* sc = (LAS float*)(F.lds + RING_OFF);
    LAS unsigned long long* bm = (LAS unsigned long long*)(F.lds + BM_OFF);
    const size_t tokb = (size_t)b * SEQ;
    if (nk <= 4) { for (int e = tid; e < 64 * nk; e += NWAVES * 64) bm[(e / nk) * 33 + (e % nk)] = ~0ull; return; }
    const int fr = lane & 15, fq = lane >> 4;
    const int ntl = (4 * nk - wave + 7) >> 3;
    for (int sb = 0; sb < 4; ++sb) {
        const int q0 = 64 * n + 16 * sb;
        {
            bf16x8 qf[8];
#pragma unroll
            for (int h = 0; h < 8; ++h) qf[h] = *(const bf16x8*)(F.P2 + (tokb + q0 + fr) * NP2 + C_QI + h * 32 + 8 * fq);
            float wv[4][8];
#pragma unroll
            for (int r = 0; r < 4; ++r) { const v4u w = *(const v4u*)(F.P2 + (tokb + q0 + 4 * fq + r) * NP2 + C_WI);
                wv[r][0] = bflo(w.x) * 0.0625f; wv[r][1] = bfhi(w.x) * 0.0625f; wv[r][2] = bflo(w.y) * 0.0625f; wv[r][3] = bfhi(w.y) * 0.0625f;
                wv[r][4] = bflo(w.z) * 0.0625f; wv[r][5] = bfhi(w.z) * 0.0625f; wv[r][6] = bflo(w.w) * 0.0625f; wv[r][7] = bfhi(w.w) * 0.0625f; }
#pragma unroll 2
            for (int i = 0; i < ntl; ++i) {
                const int key = 16 * (wave + 8 * i) + fr;
                const bf16x8 kf = *(const bf16x8*)(F.P2 + (tokb + key) * NP2 + C_KI + 8 * fq);
                f32x4 s = {0.f, 0.f, 0.f, 0.f};
#pragma unroll
                for (int h = 0; h < 8; ++h) { const f32x4 d = __builtin_amdgcn_mfma_f32_16x16x32_bf16(qf[h], kf, (f32x4){0.f, 0.f, 0.f, 0.f}, 0, 0, 0);
#pragma unroll
                    for (int r = 0; r < 4; ++r) s[r] += wv[r][h] * fmaxf(d[r], 0.f); }
#pragma unroll
                for (int r = 0; r < 4; ++r) { const int q = 4 * fq + r; sc[q * L + (key ^ (((q >> 2) & 1) << 4))] = s[r] + 0.0f; }
            }
        }
        __syncthreads();
#pragma unroll 1
        for (int which = 0; which < 2; ++which) {
            const int ql = 2 * wave + which, sw = ((ql >> 2) & 1) << 4;
            unsigned u[32];
#pragma unroll
            for (int j = 0; j < 32; ++j) u[j] = 0u;
            DSA_FOR_J( u[j] = (j < nk) ? ord_key(sc[ql * L + ((j * 64 + lane) ^ sw)]) : 0u; );
            unsigned T = 0u;
            for (int bit = 31; bit >= 0; --bit) {
                const unsigned cand = T | (1u << bit); int na = 0;
                DSA_FOR_J( na += __popcll(__ballot(u[j] >= cand)); );
                if (na >= 256) T = cand;
                if (na == 256) break;
            }
            int cg = 0;
            DSA_FOR_J( cg += __popcll(__ballot(u[j] > T)); );
            int r = 256 - cg;
            LAS unsigned long long* bmq = bm + (16 * sb + ql) * 33;
            DSA_FOR_J( { const unsigned long long mgt = __ballot(u[j] > T); unsigned long long meq = __ballot(u[j] == T); int ne = __popcll(meq);
                if (ne > r) { unsigned long long keep = 0ull, t2 = meq; for (int c = 0; c < r; ++c) { const unsigned long long low = t2 & (~t2 + 1ull); keep |= low; t2 ^= low; } meq = keep; ne = r; }
                r -= ne;
                if (lane == 0) bmq[j] = mgt | meq; } );
        }
        __syncthreads();
    }
}
__device__ __forceinline__ void dsa_attend(Frame& F, int b, int n) {
    const int lane = F.lane, h = F.wave, nk = n + 1, qq = lane & 31, hh = lane >> 5;
    const LAS unsigned* bm32 = (const LAS unsigned*)(F.lds + BM_OFF);
    const LAS float* tbw = (const LAS float*)(F.lds + TB_OFF) + h * 256;
    const size_t hb = (size_t)((b * 8 + h) * 64) * 2048;
    const bf16* Qb = F.QT + hb; const bf16* Kb = F.KT + hb; const bf16* Vb = F.VT + hb;
    constexpr float LOG2E = 1.44269504f;
    bf16x8 qf[2][4];
#pragma unroll
    for (int qt = 0; qt < 2; ++qt)
#pragma unroll
        for (int ks = 0; ks < 4; ++ks) qf[qt][ks] = *(const bf16x8*)(Qb + (size_t)(2 * n + qt) * 2048 + ks * 512 + lane * 8);
    f32x16 o[2][2];
#pragma unroll
    for (int dt = 0; dt < 2; ++dt)
#pragma unroll
        for (int qt = 0; qt < 2; ++qt)
#pragma unroll
            for (int i = 0; i < 16; ++i) o[dt][qt][i] = 0.f;
    float mrow[2] = {-1e30f, -1e30f}, lsum[2] = {0.f, 0.f};
    for (int j2 = 0; j2 < 2 * nk; ++j2) {
        bf16x8 kfr[4], vfr[2][2];
#pragma unroll
        for (int ks = 0; ks < 4; ++ks) kfr[ks] = *(const bf16x8*)(Kb + (size_t)j2 * 2048 + ks * 512 + lane * 8);
#pragma unroll
        for (int dt = 0; dt < 2; ++dt)
#pragma unroll
            for (int s = 0; s < 2; ++s) vfr[dt][s] = *(const bf16x8*)(Vb + (size_t)j2 * 2048 + dt * 1024 + s * 512 + lane * 8);
        const bool near = ((j2 >> 1) >= n - 2);
#pragma unroll
        for (int qt = 0; qt < 2; ++qt) {
            f32x16 st;
#pragma unroll
            for (int i = 0; i < 16; ++i) st[i] = 0.f;
#pragma unroll
            for (int ks = 0; ks < 4; ++ks) st = __builtin_amdgcn_mfma_f32_32x32x16_bf16(kfr[ks], qf[qt][ks], st, 0, 0, 0);
            const unsigned ww = bm32[(32 * qt + qq) * 66 + j2] >> (4 * hh);
            const int tbase = 32 * j2 - 64 * n - 32 * qt + 4 * hh - qq + 191;
            float mx = -1e30f;
#pragma unroll
            for (int i = 0; i < 16; ++i) { const int bit = (i & 3) + 8 * (i >> 2);
                float sv = st[i];
                if (near) sv += tbw[tbase + bit];
                const unsigned msk = (unsigned)__builtin_amdgcn_sbfe((int)ww, bit, 1);
                sv = __builtin_bit_cast(float, (__builtin_bit_cast(unsigned, sv) & msk) | (0xff800000u & ~msk));
                st[i] = sv; mx = fmaxf(mx, sv); }
            mx = fmaxf(mx, __shfl_xor(mx, 32));
            const float mnew = fmaxf(mrow[qt], mx), alpha = __builtin_amdgcn_exp2f((mrow[qt] - mnew) * LOG2E), mb = mnew * LOG2E;
            mrow[qt] = mnew;
            float ps = 0.f;
#pragma unroll
            for (int i = 0; i < 16; ++i) { const float p = __builtin_amdgcn_exp2f(st[i] * LOG2E - mb); st[i] = p; ps += p; }
            lsum[qt] = lsum[qt] * alpha + ps;
#pragma unroll
            for (int dt = 0; dt < 2; ++dt)
#pragma unroll
                for (int i = 0; i < 16; ++i) o[dt][qt][i] *= alpha;
#pragma unroll
            for (int s = 0; s < 2; ++s) {
                const bf16x8 pf = pack8(st[8 * s], st[8 * s + 1], st[8 * s + 2], st[8 * s + 3], st[8 * s + 4], st[8 * s + 5], st[8 * s + 6], st[8 * s + 7]);
#pragma unroll
                for (int dt = 0; dt < 2; ++dt) o[dt][qt] = __builtin_amdgcn_mfma_f32_32x32x16_bf16(vfr[dt][s], pf, o[dt][qt], 0, 0, 0);
            }
        }
    }
#pragma unroll
    for (int qt = 0; qt < 2; ++qt) {
        const float l = lsum[qt] + __shfl_xor(lsum[qt], 32), inv = 1.0f / l;
        bf16* orow = F.MIX + ((size_t)b * SEQ + 64 * n + 32 * qt + qq) * D + h * 64;
#pragma unroll
        for (int dt = 0; dt < 2; ++dt)
#pragma unroll
            for (int g = 0; g < 4; ++g) { v2u w; w.x = pk2(o[dt][qt][4 * g] * inv, o[dt][qt][4 * g + 1] * inv); w.y = pk2(o[dt][qt][4 * g + 2] * inv, o[dt][qt][4 * g + 3] * inv);
                *(v2u*)(orow + 32 * dt + 8 * g + 4 * hh) = w; }
    }
}
__device__ __forceinline__ void dsa_fast(Frame& F) {
    dsa_bias_table(F);
    __syncthreads();
    for (;;) {
        if (F.tid == 0) F.MISC[16] = atomicAdd(F.ctl + CW_QUEUE, 1u);
        __syncthreads();
        const unsigned id = F.MISC[16];
        if (id >= (unsigned)(BATCH * NCHUNK)) break;
        const int n = NCHUNK - 1 - (int)(id >> 4), b = (int)(id & 15);
        dsa_select(F, b, n);
        __syncthreads();
        dsa_attend(F, b, n);
        __syncthreads();
    }
}

__device__ __forceinline__ void gla_simple(Frame& F) {
    LAS float* qin = (LAS float*)(F.lds + RING_OFF);
    LAS float* kin = qin + 64 * 65;
    LAS float* att = kin + 64 * 65;
    LAS float* vv = att + 64 * 65;
    LAS float* S = vv + 64 * 128;
    LAS float* gd = S + 64 * 128;
    LAS float* Wg = gd + 64 * 16;
    LAS float* bg = Wg + 16 * 64;
    LAS float* ebl = bg + 64;
    const int tid = F.tid, lane = F.lane, wave = F.wave;
    for (int unit = blockIdx.x; unit < BATCH * 4; unit += F.G) {
        const int b = unit >> 2, h = unit & 3;
        for (int e = tid; e < 1024; e += 512) Wg[e] = F.w_gate_up[(e >> 6) * 256 + h * 64 + (e & 63)];
        if (tid < 64) bg[tid] = F.b_gate[h * 64 + tid];
        for (int e = tid; e < 8192; e += 512) S[e] = 0.f;
        __syncthreads();
        for (int n = 0; n < NCHUNK; ++n) {
            const size_t tok0 = (size_t)b * SEQ + n * CHUNK;
            for (int e = tid; e < 1024; e += 512) gd[e] = bf2f(F.P2[(tok0 + (e >> 4)) * NP2 + C_GD + (e & 15)]);
            __syncthreads();
            for (int e = tid; e < 4096; e += 512) { const int t = e >> 6, d = e & 63; float xg = bg[d];
#pragma unroll
                for (int r = 0; r < 16; ++r) xg += gd[t * 16 + r] * Wg[r * 64 + d];
                att[t * 65 + d] = (fminf(xg, 0.f) - log1pf(__expf(-fabsf(xg)))) * (1.0f / 16.0f); }
            __syncthreads();
            if (tid < 64) { float run = 0.f; for (int t = 0; t < 64; ++t) { run += att[t * 65 + tid]; att[t * 65 + tid] = run; } ebl[tid] = __expf(run); }
            __syncthreads();
            for (int e = tid; e < 4096; e += 512) { const int t = e >> 6, d = e & 63; const float bc = att[t * 65 + d];
                const float q = bf2f(F.P2[(tok0 + t) * NP2 + C_QB + h * 64 + d]), k = bf2f(F.P2[(tok0 + t) * NP2 + C_KB + h * 64 + d]);
                qin[t * 65 + d] = q * 0.125f * __expf(bc); kin[t * 65 + d] = k * __expf(-bc); }
            for (int e = tid; e < 8192; e += 512) vv[e] = bf2f(F.P2[(tok0 + (e >> 7)) * NP2 + C_VB + h * 128 + (e & 127)]);
            __syncthreads();
            for (int e = tid; e < 4096; e += 512) { const int t = e >> 6, s = e & 63; float a = 0.f;
                if (s <= t) {
#pragma unroll 8
                    for (int d = 0; d < 64; ++d) a += qin[t * 65 + d] * kin[s * 65 + d]; }
                att[t * 65 + s] = a; }
            __syncthreads();
            const int v = tid & 127, q4 = tid >> 7; float o[16];
#pragma unroll
            for (int i = 0; i < 16; ++i) { const int t = q4 * 16 + i; float a = 0.f;
                for (int s = 0; s <= t; ++s) a += att[t * 65 + s] * vv[s * 128 + v];
#pragma unroll 8
                for (int d = 0; d < 64; ++d) a += qin[t * 65 + d] * S[d * 128 + v];
                o[i] = a; }
            __syncthreads();
#pragma unroll 1
            for (int i = 0; i < 16; ++i) { const int d = q4 * 16 + i; float a = 0.f;
#pragma unroll 8
                for (int s = 0; s < 64; ++s) a += kin[s * 65 + d] * vv[s * 128 + v];
                S[d * 128 + v] = ebl[d] * (S[d * 128 + v] + a); }
            __syncthreads();
#pragma unroll
            for (int i = 0; i < 16; ++i) vv[(q4 * 16 + i) * 128 + v] = o[i];
            __syncthreads();
            for (int r = 0; r < 8; ++r) { const int t = wave * 8 + r; const float x0 = vv[t * 128 + lane], x1 = vv[t * 128 + 64 + lane];
                const float rr = 1.0f / sqrtf(wave_sum(x0 * x0 + x1 * x1) * (1.0f / 128.0f) + EPS);
                const float g0 = bf2f(F.P2[(tok0 + t) * NP2 + C_OG + h * 128 + lane]), g1 = bf2f(F.P2[(tok0 + t) * NP2 + C_OG + h * 128 + 64 + lane]);
                const float y0 = x0 * rr * F.gla_norm[h * 128 + lane] * (g0 / (1.0f + __expf(-g0))), y1 = x1 * rr * F.gla_norm[h * 128 + 64 + lane] * (g1 / (1.0f + __expf(-g1)));
                F.MIX[(tok0 + t) * D + 512 + h * 128 + lane] = (bf16)f2bf(y0); F.MIX[(tok0 + t) * D + 512 + h * 128 + 64 + lane] = (bf16)f2bf(y1); }
            __syncthreads();
        }
    }
}

__device__ __forceinline__ void p6_final(Frame& F) {
    const int gw = blockIdx.x * NWAVES + F.wave, NGW = F.G * NWAVES, lane = F.lane;
    for (int m = gw; m < M; m += NGW) {
        const f32x4* rp = (const f32x4*)(F.RS2 + (size_t)m * 16); const f32x4 p0 = rp[0], p1 = rp[1], p2 = rp[2], p3 = rp[3];
        const float ssq = ((p0[0] + p0[1]) + (p0[2] + p0[3])) + ((p1[0] + p1[1]) + (p1[2] + p1[3])) + ((p2[0] + p2[1]) + (p2[2] + p2[3])) + ((p3[0] + p3[1]) + (p3[2] + p3[3]));
        const float r = 1.0f / sqrtf(ssq * (1.0f / D) + EPS);
        f32x4* xr = (f32x4*)(F.out + (size_t)m * D) + lane; const f32x4* gr = (const f32x4*)F.norm_final + lane;
#pragma unroll
        for (int j = 0; j < 4; ++j) { const f32x4 v = xr[64 * j], g = gr[64 * j]; xr[64 * j] = v * r * g; }
    }
}

struct Args { const float* in[13]; float* out; unsigned char* ws; int ph_lo, ph_hi; };
__global__ void __launch_bounds__(NWAVES * 64, 2) fwd(Args args) {
    extern __shared__ __attribute__((aligned(16))) unsigned char lds[];
    Frame F;
    F.lds = (LAS unsigned char*)lds;
    F.MISC = (volatile LAS unsigned*)(F.lds + MISC_OFF);
    F.tid = threadIdx.x; F.lane = F.tid & 63; F.wave = __builtin_amdgcn_readfirstlane(F.tid >> 6);
    F.G = gridDim.x;
    unsigned char* ws = args.ws;
    F.ctl = (unsigned*)(ws + WS_CTL);
    F.x = args.in[0]; F.norm_mix = args.in[1]; F.w_in = args.in[2]; F.w_gate_up = args.in[3]; F.b_gate = args.in[4]; F.gla_norm = args.in[5]; F.w_out = args.in[6]; F.rel_bias = args.in[7];
    F.norm_ffn = args.in[8]; F.w_ffn_gate = args.in[9]; F.w_ffn_up = args.in[10]; F.w_ffn_down = args.in[11]; F.norm_final = args.in[12]; F.out = args.out;
    F.WIN = (bf16*)(ws + WS_WIN); F.WOUT = (bf16*)(ws + WS_WOUT); F.WGU = (bf16*)(ws + WS_WGU); F.WDN = (bf16*)(ws + WS_WDN);
    F.H = (bf16*)(ws + WS_H); F.QT = (bf16*)(ws + WS_QT); F.KT = (bf16*)(ws + WS_KT); F.VT = (bf16*)(ws + WS_VT); F.P2 = (bf16*)(ws + WS_P2); F.MIX = (bf16*)(ws + WS_MIX); F.ACT = (bf16*)(ws + WS_ACT);
    F.RS1 = (float*)(ws + WS_RS1); F.RS2 = (float*)(ws + WS_RS2);
    for (int u = F.tid; u < (LDS_BYTES - LDSCTL_OFF) / 4; u += NWAVES * 64) ((LAS unsigned*)(F.lds + LDSCTL_OFF))[u] = 0u;
    __syncthreads();
    XcdBarrier bar; bar.bar = F.ctl + CW_BAR; bar.x = 0; bar.st = nullptr;
    if (N_LAUNCHES == 1) bar = xcd_barrier_post(F.ctl + CW_BAR, F.MISC + 8);
    const int lo = args.ph_lo, hi = args.ph_hi;
#define IN(k) (lo <= (k) && (k) < hi)
#define SEAM(k) do { if (IN(k) && IN((k) + 1)) xcd_barrier(bar); } while (0)

    if (IN(0)) { p0_prologue(F); }
    SEAM(0);
    if (IN(1)) {
        { pg8::Gemm g{F.H, F.WIN, M, 3072, D}; pg8::StaticOrder S; S.init(M, 3072, F.G, (int)blockIdx.x);
          pg8::EpiProjA E{F.QT, F.KT, F.P2};
          pg8::gemm_phase<pg8::EpiProjA, pg8::StaticOrder, true, true, false>(F.lds + RING_OFF, g, S, E); }
        { pg8::Gemm g{F.H, F.WIN + (size_t)3072 * D, M, 512, D}; pg8::StaticOrder S; S.init(M, 512, F.G, (int)blockIdx.x);
          pg8::EpiVT E{F.VT};
          pg8::gemm_phase<pg8::EpiVT, pg8::StaticOrder, true, true, true>(F.lds + RING_OFF, g, S, E); }
    }
    SEAM(1);
    if (IN(2)) { gla_simple(F); __syncthreads(); dsa_fast(F); }
    SEAM(2);
    if (IN(3)) {
        pg8::Gemm g{F.MIX, F.WOUT, M, D, D}; pg8::StaticOrder S; S.init(M, D, F.G, (int)blockIdx.x);
        pg8::EpiOut E{F.x, F.out, F.H, F.norm_ffn, F.RS1};
        pg8::gemm_phase<pg8::EpiOut, pg8::StaticOrder, true, true>(F.lds + RING_OFF, g, S, E);
    }
    SEAM(3);
    if (IN(4)) {
        pg8::Gemm g{F.H, F.WGU, M, NGU, D}; pg8::StaticOrder S; S.init(M, NGU, F.G, (int)blockIdx.x);
        pg8::EpiGU E{F.RS1, F.ACT, EPS};
        pg8::gemm_phase<pg8::EpiGU, pg8::StaticOrder, true, true>(F.lds + RING_OFF, g, S, E);
    }
    SEAM(4);
    if (IN(5)) {
        pg8::Gemm g{F.ACT, F.WDN, M, D, FF}; pg8::StaticOrder S; S.init(M, D, F.G, (int)blockIdx.x);
        pg8::EpiDown E{F.out, F.RS2};
        pg8::gemm_phase<pg8::EpiDown, pg8::StaticOrder, true, true>(F.lds + RING_OFF, g, S, E);
    }
    SEAM(5);
    if (IN(6)) { p6_final(F); }
#undef IN
#undef SEAM
}

extern "C" void kernel_launch(void* const* d_in, const int* in_sizes, int n_in, void* d_out, int out_size, void* d_ws, size_t ws_size, hipStream_t stream) {
    static int grid = 0;
    if (grid == 0) {
        if (n_in != 13 || in_sizes[0] != M * D || out_size != M * D || ws_size < WS_END) { fprintf(stderr, "kernel_launch: unexpected shapes (n_in %d, in0 %d, out %d, ws %zu)\n", n_in, n_in > 0 ? in_sizes[0] : -1, out_size, ws_size); grid = -1; return; }
        int dev = 0, cus = 0, per_cu = 0;
        if (hipGetDevice(&dev) != hipSuccess || hipDeviceGetAttribute(&cus, hipDeviceAttributeMultiprocessorCount, dev) != hipSuccess) { grid = -1; return; }
        if (hipFuncSetAttribute((const void*)fwd, hipFuncAttributeMaxDynamicSharedMemorySize, LDS_BYTES) != hipSuccess) { fprintf(stderr, "kernel_launch: hipFuncSetAttribute failed\n"); grid = -1; return; }
        if (hipOccupancyMaxActiveBlocksPerMultiprocessor(&per_cu, (const void*)fwd, NWAVES * 64, LDS_BYTES) != hipSuccess || per_cu < 1) fprintf(stderr, "kernel_launch: occupancy query reports %d\n", per_cu);
        (void)hipGetLastError();
        grid = cus;
    }
    if (grid < 0) return;
    (void)hipMemsetAsync((char*)d_ws + WS_CTL, 0, CTL_ZERO_BYTES, stream);
    Args a{};
    for (int i = 0; i < 13; ++i) a.in[i] = (const float*)d_in[i];
    a.out = (float*)d_out; a.ws = (unsigned char*)d_ws;
    if (N_LAUNCHES == 1) { a.ph_lo = 0; a.ph_hi = N_PHASES; hipLaunchKernelGGL(fwd, dim3(grid), dim3(NWAVES * 64), LDS_BYTES, stream, a); }
    else for (int p = 0; p < N_PHASES; ++p) { a.ph_lo = p; a.ph_hi = p + 1; hipLaunchKernelGGL(fwd, dim3(grid), dim3(NWAVES * 64), LDS_BYTES, stream, a); }
}
```

```cpp
#include <hip/hip_runtime.h>
#include <cstdio>
#include <cstdint>
namespace pg8 {
#define PG8_LAS __attribute__((address_space(3)))
typedef unsigned short bf16_t;
typedef short bf16x8 __attribute__((ext_vector_type(8)));
typedef float f32x4 __attribute__((ext_vector_type(4)));
typedef unsigned u32x4 __attribute__((ext_vector_type(4)));
constexpr int BM = 256, BK = 64, HALF = 128, HTB = HALF * BK * 2  , STAGE_BYTES = 8 * HTB, NXCD = 8, WGM = 8;

__host__ __device__ __forceinline__ int lds_byte(int r, int c) { const int st = (r >> 4) * 2 + (c >> 5), rr = r & 15, cc = c & 31, ob = rr * 64 + cc * 2; return st * 1024 + (ob ^ (((ob >> 9) & 1) << 5)); }
__host__ __device__ __forceinline__ void stage_rc(int b, int& R, int& C) { const int st = b / 1024, sb = b % 1024, swz = sb ^ (((sb >> 9) & 1) << 5); R = (st >> 1) * 16 + swz / 64; C = (st & 1) * 32 + (swz % 64) / 2; }
__host__ __device__ __forceinline__ int perm32(int rho) { const int n = rho >> 4, i = rho & 15; return 8 * (i >> 2) + 4 * n + (i & 3); }

struct Unit { int pm, pn; };
struct Gemm { const bf16_t* A; const bf16_t* Bt; int M, N, K; };

struct StaticOrder {
    int nM, nN, nwg, G, c;
    __host__ __device__ void init(int M, int N, int G_, int c_) { nM = M / BM; nN = N / BM; nwg = nM * nN; G = G_; c = c_; }
    __host__ __device__ bool next(int i, Unit& u) const {
        const long L = (long)i * G + c; if (L >= nwg) return false;
        int wgid = (int)L; { const int q = nwg / NXCD, r = nwg % NXCD, xcd = wgid % NXCD, off = wgid / NXCD; wgid = (xcd < r ? xcd * (q + 1) : r * (q + 1) + (xcd - r) * q) + off; }
        const int nig = WGM * nN, gid = wgid / nig, fm = gid * WGM, gsz = (nM - fm) < WGM ? (nM - fm) : WGM;
        u.pm = fm + ((wgid % nig) % gsz); u.pn = (wgid % nig) / gsz; return true;
    }
    __device__ __forceinline__ void a_ready(const Unit&) const {}
    __device__ __forceinline__ void done(const Unit&) const {}
};

__device__ __forceinline__ unsigned cvt_pk_bf16(float lo, float hi) { unsigned r; asm volatile("v_cvt_pk_bf16_f32 %0, %1, %2" : "=v"(r) : "v"(lo), "v"(hi)); return r; }
typedef float f32x2 __attribute__((ext_vector_type(2)));
__device__ __forceinline__ f32x2 gelu_pk(f32x2 v) {
    const f32x2 av = __builtin_elementwise_abs(v), d = av * 0.2316418882f + 1.0f;
    f32x2 t; t.x = __builtin_amdgcn_rcpf(d.x); t.y = __builtin_amdgcn_rcpf(d.y);
    f32x2 q = t * 0.5307027145f + (-0.7265760135f); q = q * t + 0.7107068705f; q = q * t + (-0.142248368f); q = q * t + 0.127414796f; q = q * t;
    const f32x2 s = (v * v) * (-0.72134752044f);
    f32x2 e; e.x = __builtin_amdgcn_exp2f(s.x); e.y = __builtin_amdgcn_exp2f(s.y);
    const f32x2 m = v * (q * e), r = v - m;
    f32x2 o; o.x = v.x < 0.f ? m.x : r.x; o.y = v.y < 0.f ? m.y : r.y; return o;
}

template <int ACT  > struct EpiBf16 {
    static constexpr bool PERM = true, AFTER_DRAIN = false; static_assert(ACT == 0 || ACT == 1, "EpiBf16: ACT is 0 (none) or 1 (gelu_pk)");
    bf16_t* O; int ldc; const float* bias; int split_cols; size_t split_stride; float scale0;
    __device__ __forceinline__ void operator()(const f32x4 (&acc)[2][2][4][2], const Unit& u, int wr, int wc, int fr, int fq) const {
        const int row0 = u.pm * BM + wr * 64 + fr; int colt = u.pn * BM; bf16_t* base = O;
        float sc = 1.f; if (split_cols) { const int t = colt / split_cols; base += (size_t)t * split_stride; colt -= t * split_cols; if (t == 0) sc = scale0; }
        const int col0 = colt + wc * 32 + 8 * fq, bcol0 = u.pn * BM + wc * 32 + 8 * fq;
        f32x4 bv[2][2];
#pragma unroll
        for (int bj = 0; bj < 2; ++bj)
#pragma unroll
            for (int n = 0; n < 2; ++n) bv[bj][n] = bias ? *(const f32x4*)(bias + bcol0 + bj * HALF + 4 * n) : (f32x4){0.f, 0.f, 0.f, 0.f};
#pragma unroll
        for (int ai = 0; ai < 2; ++ai)
#pragma unroll
            for (int m = 0; m < 4; ++m) { bf16_t* rowp = base + (size_t)(row0 + ai * HALF + m * 16) * ldc + col0;
#pragma unroll
                for (int bj = 0; bj < 2; ++bj) { f32x4 v0 = acc[ai][bj][m][0] + bv[bj][0], v1 = acc[ai][bj][m][1] + bv[bj][1];
                    if (ACT == 1) { f32x2 a = gelu_pk((f32x2){v0[0], v0[1]}), b = gelu_pk((f32x2){v0[2], v0[3]}), c = gelu_pk((f32x2){v1[0], v1[1]}), d = gelu_pk((f32x2){v1[2], v1[3]});
                        v0 = (f32x4){a.x, a.y, b.x, b.y}; v1 = (f32x4){c.x, c.y, d.x, d.y}; }
                    v0 = v0 * sc; v1 = v1 * sc; u32x4 w; w.x = cvt_pk_bf16(v0[0], v0[1]); w.y = cvt_pk_bf16(v0[2], v0[3]); w.z = cvt_pk_bf16(v1[0], v1[1]); w.w = cvt_pk_bf16(v1[2], v1[3]);
                    *(u32x4*)(rowp + bj * HALF) = w; } }
    }
};
struct EpiOut {
    static constexpr bool PERM = true, AFTER_DRAIN = false;
    const float* x; float* x1; bf16_t* hn; const float* g; float* rs;
    __device__ __forceinline__ void operator()(const f32x4 (&acc)[2][2][4][2], const Unit& u, int wr, int wc, int fr, int fq) const {
        const int row0 = u.pm * BM + wr * 64 + fr, col0 = u.pn * BM + wc * 32 + 8 * fq;
        f32x4 gv[2][2];
#pragma unroll
        for (int bj = 0; bj < 2; ++bj)
#pragma unroll
            for (int n = 0; n < 2; ++n) gv[bj][n] = *(const f32x4*)(g + col0 + bj * HALF + 4 * n);
#pragma unroll
        for (int ai = 0; ai < 2; ++ai)
#pragma unroll
            for (int m = 0; m < 4; ++m) { const int row = row0 + ai * HALF + m * 16; const size_t off = (size_t)row * 1024 + col0; float ss = 0.f;
#pragma unroll
                for (int bj = 0; bj < 2; ++bj) {
                    const f32x4 xa = *(const f32x4*)(x + off + bj * HALF), xb = *(const f32x4*)(x + off + bj * HALF + 4);
                    const f32x4 v0 = acc[ai][bj][m][0] + xa, v1 = acc[ai][bj][m][1] + xb;
                    *(f32x4*)(x1 + off + bj * HALF) = v0; *(f32x4*)(x1 + off + bj * HALF + 4) = v1;
                    ss += (v0[0] * v0[0] + v0[1] * v0[1]) + (v0[2] * v0[2] + v0[3] * v0[3]) + (v1[0] * v1[0] + v1[1] * v1[1]) + (v1[2] * v1[2] + v1[3] * v1[3]);
                    const f32x4 h0 = v0 * gv[bj][0], h1 = v1 * gv[bj][1];
                    u32x4 w; w.x = cvt_pk_bf16(h0[0], h0[1]); w.y = cvt_pk_bf16(h0[2], h0[3]); w.z = cvt_pk_bf16(h1[0], h1[1]); w.w = cvt_pk_bf16(h1[2], h1[3]);
                    *(u32x4*)(hn + off + bj * HALF) = w; }
                ss += __shfl_xor(ss, 16); ss += __shfl_xor(ss, 32);
                if (fq == 0) rs[(size_t)row * 16 + u.pn * 4 + wc] = ss; }
    }
};
struct EpiGU {
    static constexpr bool PERM = true, AFTER_DRAIN = false;
    const float* rs; bf16_t* act; float eps;
    __device__ __forceinline__ void operator()(const f32x4 (&acc)[2][2][4][2], const Unit& u, int wr, int wc, int fr, int fq) const {
        const int row0 = u.pm * BM + wr * 64 + fr, col0 = u.pn * HALF + wc * 32 + 8 * fq;
#pragma unroll
        for (int ai = 0; ai < 2; ++ai)
#pragma unroll
            for (int m = 0; m < 4; ++m) { const int row = row0 + ai * HALF + m * 16;
                const f32x4* rp = (const f32x4*)(rs + (size_t)row * 16); const f32x4 p0 = rp[0], p1 = rp[1], p2 = rp[2], p3 = rp[3];
                const float ssq = ((p0[0] + p0[1]) + (p0[2] + p0[3])) + ((p1[0] + p1[1]) + (p1[2] + p1[3])) + ((p2[0] + p2[1]) + (p2[2] + p2[3])) + ((p3[0] + p3[1]) + (p3[2] + p3[3]));
                const float r = 1.0f / sqrtf(ssq * (1.0f / 1024.0f) + eps);
                float a[8];
#pragma unroll
                for (int n = 0; n < 2; ++n)
#pragma unroll
                    for (int j = 0; j < 4; ++j) { const float gg = acc[ai][0][m][n][j] * r, uu = acc[ai][1][m][n][j] * r;
                        a[4 * n + j] = gg * __builtin_amdgcn_rcpf(1.0f + __builtin_amdgcn_exp2f(gg * -1.44269504f)) * uu; }
                u32x4 w; w.x = cvt_pk_bf16(a[0], a[1]); w.y = cvt_pk_bf16(a[2], a[3]); w.z = cvt_pk_bf16(a[4], a[5]); w.w = cvt_pk_bf16(a[6], a[7]);
                *(u32x4*)(act + (size_t)row * 2816 + col0) = w; }
    }
};
struct EpiDown {
    static constexpr bool PERM = true, AFTER_DRAIN = false;
    float* xio; float* rs;
    __device__ __forceinline__ void operator()(const f32x4 (&acc)[2][2][4][2], const Unit& u, int wr, int wc, int fr, int fq) const {
        const int row0 = u.pm * BM + wr * 64 + fr, col0 = u.pn * BM + wc * 32 + 8 * fq;
#pragma unroll
        for (int ai = 0; ai < 2; ++ai)
#pragma unroll
            for (int m = 0; m < 4; ++m) { const int row = row0 + ai * HALF + m * 16; const size_t off = (size_t)row * 1024 + col0; float ss = 0.f;
#pragma unroll
                for (int bj = 0; bj < 2; ++bj) {
                    const f32x4 xa = *(const f32x4*)(xio + off + bj * HALF), xb = *(const f32x4*)(xio + off + bj * HALF + 4);
                    const f32x4 v0 = acc[ai][bj][m][0] + xa, v1 = acc[ai][bj][m][1] + xb;
                    *(f32x4*)(xio + off + bj * HALF) = v0; *(f32x4*)(xio + off + bj * HALF + 4) = v1;
                    ss += (v0[0] * v0[0] + v0[1] * v0[1]) + (v0[2] * v0[2] + v0[3] * v0[3]) + (v1[0] * v1[0] + v1[1] * v1[1]) + (v1[2] * v1[2] + v1[3] * v1[3]); }
                ss += __shfl_xor(ss, 16); ss += __shfl_xor(ss, 32);
                if (fq == 0) rs[(size_t)row * 16 + u.pn * 4 + wc] = ss; }
    }
};
struct EpiProjA {
    static constexpr bool PERM = true, AFTER_DRAIN = false;
    bf16_t* QT; bf16_t* KT; bf16_t* P2;
    __device__ __forceinline__ void operator()(const f32x4 (&acc)[2][2][4][2], const Unit& u, int wr, int wc, int fr, int fq) const {
        const int row0 = u.pm * BM + wr * 64 + fr;
        if (u.pn < 4) {
            bf16_t* dst = (u.pn < 2) ? QT : KT; const float sc = (u.pn < 2) ? 0.125f : 1.0f;
#pragma unroll
            for (int bj = 0; bj < 2; ++bj) { const int c = (u.pn & 1) * BM + bj * HALF + wc * 32 + 8 * fq, h = c >> 6, p = (c & 63) >> 3;
#pragma unroll
                for (int ai = 0; ai < 2; ++ai)
#pragma unroll
                    for (int m = 0; m < 4; ++m) { const int row = row0 + ai * HALF + m * 16, b = row >> 11, t = row & 2047;
                        const f32x4 v0 = acc[ai][bj][m][0] * sc, v1 = acc[ai][bj][m][1] * sc;
                        u32x4 w; w.x = cvt_pk_bf16(v0[0], v0[1]); w.y = cvt_pk_bf16(v0[2], v0[3]); w.z = cvt_pk_bf16(v1[0], v1[1]); w.w = cvt_pk_bf16(v1[2], v1[3]);
                        *(u32x4*)(dst + ((size_t)((b * 8 + h) * 64 + (t >> 5)) * 2048 + (p >> 1) * 512 + ((p & 1) * 32 + (t & 31)) * 8)) = w; } }
        } else {
            const int col0 = (u.pn - 4) * BM + wc * 32 + 8 * fq;
#pragma unroll
            for (int ai = 0; ai < 2; ++ai)
#pragma unroll
                for (int m = 0; m < 4; ++m) { bf16_t* rowp = P2 + (size_t)(row0 + ai * HALF + m * 16) * 2048 + col0;
#pragma unroll
                    for (int bj = 0; bj < 2; ++bj) { const f32x4 v0 = acc[ai][bj][m][0], v1 = acc[ai][bj][m][1];
                        u32x4 w; w.x = cvt_pk_bf16(v0[0], v0[1]); w.y = cvt_pk_bf16(v0[2], v0[3]); w.z = cvt_pk_bf16(v1[0], v1[1]); w.w = cvt_pk_bf16(v1[2], v1[3]);
                        *(u32x4*)(rowp + bj * HALF) = w; } }
        }
    }
};
struct EpiVT {
    static constexpr bool PERM = false, AFTER_DRAIN = false;
    bf16_t* VT;
    __device__ __forceinline__ void operator()(const f32x4 (&acc)[2][2][4][2], const Unit& u, int wr, int wc, int fr, int fq) const {
#pragma unroll
        for (int bj = 0; bj < 2; ++bj)
#pragma unroll
            for (int n = 0; n < 2; ++n) { const int c = u.pn * BM + bj * HALF + wc * 32 + 16 * n + fr, h = c >> 6, d = c & 63;
#pragma unroll
                for (int ai = 0; ai < 2; ++ai)
#pragma unroll
                    for (int m = 0; m < 4; ++m) { const int row = u.pm * BM + ai * HALF + wr * 64 + m * 16 + 4 * fq, b = row >> 11, t = row & 2047;
                        const f32x4 v = acc[ai][bj][m][n];
                        unsigned lo = cvt_pk_bf16(v[0], v[1]), hi = cvt_pk_bf16(v[2], v[3]);
                        typedef unsigned u32x2 __attribute__((ext_vector_type(2)));
                        u32x2 w; w.x = lo; w.y = hi;
                        *(u32x2*)(VT + ((size_t)((b * 8 + h) * 64 + (t >> 5)) * 2048 + (d >> 5) * 1024 + ((t >> 4) & 1) * 512 + ((((t >> 2) & 1) * 32) + (d & 31)) * 8 + 4 * ((t >> 3) & 1))) = w; } }
    }
};
template <class Epi, class Sched, bool ALIGN_EPI = false, bool SP2 = false, bool SWAP = false>
__device__ __forceinline__ void gemm_phase(PG8_LAS unsigned char* lds, const Gemm g, const Sched& S, const Epi& E) {
    const int tid = threadIdx.x, wid = __builtin_amdgcn_readfirstlane(tid >> 6), lane = tid & 63, wr = wid >> 2, wc = wid & 3, fr = lane & 15, fq = lane >> 4;
    const int K = g.K, nt = K / BK;
    unsigned voffA[2], voffB[2];
#pragma unroll
    for (int i = 0; i < 2; ++i) { int R, C; stage_rc(tid * 16 + i * 8192, R, C); const int Rb = Epi::PERM ? ((R & ~31) + perm32(R & 31)) : R;
        voffA[i] = (unsigned)(R * K + C) * 2u; voffB[i] = (unsigned)(Rb * K + C) * 2u; }
    const size_t kstep = (size_t)(BK * 2);
    const size_t hstep = (size_t)HALF * K * 2;
    const size_t tstep = 2 * hstep;
    const unsigned ldsw = (unsigned)wid * 1024u;
    const int aoff = lds_byte(wr * 64 + fr, fq * 8), boff = lds_byte(wc * 32 + fr, fq * 8);
#define PG8_SA(b, h) (((b) * 2 + (h)) * HTB)
#define PG8_SB(b, h) ((4 + (b) * 2 + (h)) * HTB)
#define PG8_STAGE(bufoff, gbase, voff) do { _Pragma("unroll") for (int _i = 0; _i < 2; ++_i) \
        __builtin_amdgcn_global_load_lds((const unsigned*)((const char*)(gbase) + (voff)[_i]), (PG8_LAS unsigned*)(lds + (bufoff) + ldsw + _i * 8192), 16, 0, 0); } while (0)
#define PG8_LDA(dst, b, h) do { _Pragma("unroll") for (int m = 0; m < 4; ++m) _Pragma("unroll") for (int k = 0; k < 2; ++k) dst[m][k] = *(const PG8_LAS bf16x8*)(lds + PG8_SA(b, h) + aoff + m * 2048 + k * 1024); } while (0)
#define PG8_LDB(dst, b, h) do { _Pragma("unroll") for (int n = 0; n < 2; ++n) _Pragma("unroll") for (int k = 0; k < 2; ++k) dst[n][k] = *(const PG8_LAS bf16x8*)(lds + PG8_SB(b, h) + boff + n * 2048 + k * 1024); } while (0)
#define PG8_MMA(ai, bj, At, Bt) do { __builtin_amdgcn_s_setprio(1); _Pragma("unroll") for (int m = 0; m < 4; ++m) _Pragma("unroll") for (int n = 0; n < 2; ++n) _Pragma("unroll") for (int k = 0; k < 2; ++k) \
        { if constexpr (SWAP) acc[ai][bj][m][n] = __builtin_amdgcn_mfma_f32_16x16x32_bf16(At[m][k], Bt[n][k], acc[ai][bj][m][n], 0, 0, 0); else acc[ai][bj][m][n] = __builtin_amdgcn_mfma_f32_16x16x32_bf16(Bt[n][k], At[m][k], acc[ai][bj][m][n], 0, 0, 0); } __builtin_amdgcn_s_setprio(0); } while (0)
#define PG8_WAIT_V(n) asm volatile("s_waitcnt vmcnt(" #n ")" ::: "memory")
#define PG8_WAIT_L(n) asm volatile("s_waitcnt lgkmcnt(" #n ")" ::: "memory")
#define PG8_BAR __builtin_amdgcn_s_barrier()
#define PG8_SCHED __builtin_amdgcn_sched_barrier(0)
    Unit cur, nxt; int ui = 0;
    if (!S.next(0, cur)) return;
    f32x4 acc[2][2][4][2];
#pragma unroll
    for (int a = 0; a < 2; ++a)
#pragma unroll
        for (int b = 0; b < 2; ++b)
#pragma unroll
            for (int m = 0; m < 4; ++m)
#pragma unroll
                for (int n = 0; n < 2; ++n) acc[a][b][m][n] = (f32x4){0.f, 0.f, 0.f, 0.f};
    bf16x8 At[4][2], B0[2][2], B1[2][2];
    const char* cA = (const char*)g.A + (size_t)cur.pm * tstep; const char* cB = (const char*)g.Bt + (size_t)cur.pn * tstep;
    S.a_ready(cur);
    if constexpr (SP2) {
        PG8_STAGE(PG8_SB(0, 0), cB, voffB); PG8_STAGE(PG8_SB(0, 1), cB + hstep, voffB); PG8_STAGE(PG8_SA(0, 0), cA, voffA); PG8_STAGE(PG8_SA(0, 1), cA + hstep, voffA);
        if (wr == 1) PG8_BAR;
        PG8_WAIT_V(2); PG8_BAR;
        PG8_STAGE(PG8_SB(1, 0), cB + kstep, voffB); PG8_STAGE(PG8_SA(1, 0), cA + kstep, voffA); PG8_STAGE(PG8_SB(1, 1), cB + hstep + kstep, voffB);
        PG8_WAIT_V(6); PG8_BAR;
    } else {
        PG8_STAGE(PG8_SB(0, 0), cB, voffB); PG8_STAGE(PG8_SA(0, 0), cA, voffA); PG8_STAGE(PG8_SB(0, 1), cB + hstep, voffB); PG8_STAGE(PG8_SA(0, 1), cA + hstep, voffA);
        if (wr == 1) PG8_BAR;
        PG8_WAIT_V(4); PG8_BAR;
        PG8_STAGE(PG8_SB(1, 0), cB + kstep, voffB); PG8_STAGE(PG8_SA(1, 0), cA + kstep, voffA); PG8_STAGE(PG8_SB(1, 1), cB + hstep + kstep, voffB);
        PG8_WAIT_V(6); PG8_BAR;
    }
    for (;;) {
        const bool has_next = S.next(ui + 1, nxt);
        const char* nA = has_next ? (const char*)g.A + (size_t)nxt.pm * tstep : cA; const char* nB = has_next ? (const char*)g.Bt + (size_t)nxt.pn * tstep : cB;
        for (int t = 0; t < nt; t += 2) {
            const bool last = (t == nt - 2);
            const char* a1 = cA + (size_t)(t + 1) * kstep;
            const char* a2 = last ? nA : cA + (size_t)(t + 2) * kstep; const char* b2 = last ? nB : cB + (size_t)(t + 2) * kstep;
            const char* a3 = a2 + kstep; const char* b3 = b2 + kstep;
            if (last && has_next) S.a_ready(nxt);
            if constexpr (SP2) {
            PG8_LDB(B0, 0, 0); PG8_LDB(B1, 0, 1); PG8_SCHED; PG8_LDA(At, 0, 0); PG8_STAGE(PG8_SA(1, 1), a1 + hstep, voffA);
            PG8_WAIT_V(8); PG8_WAIT_L(0); PG8_BAR; PG8_MMA(0, 0, At, B0); PG8_MMA(0, 1, At, B1); PG8_BAR; PG8_SCHED;
            PG8_LDA(At, 0, 1); PG8_STAGE(PG8_SB(0, 0), b2, voffB); PG8_STAGE(PG8_SB(0, 1), b2 + hstep, voffB); PG8_STAGE(PG8_SA(0, 0), a2, voffA);
            PG8_WAIT_V(8); PG8_WAIT_L(0); PG8_BAR; PG8_MMA(1, 0, At, B0); PG8_MMA(1, 1, At, B1); PG8_BAR; PG8_SCHED;
            PG8_LDB(B0, 1, 0); PG8_LDB(B1, 1, 1); PG8_SCHED; PG8_LDA(At, 1, 0); PG8_STAGE(PG8_SA(0, 1), a2 + hstep, voffA);
            PG8_WAIT_V(8); PG8_WAIT_L(0); PG8_BAR; PG8_MMA(0, 0, At, B0); PG8_MMA(0, 1, At, B1); PG8_BAR; PG8_SCHED;
            PG8_LDA(At, 1, 1); PG8_STAGE(PG8_SB(1, 0), b3, voffB); PG8_STAGE(PG8_SB(1, 1), b3 + hstep, voffB); PG8_STAGE(PG8_SA(1, 0), a3, voffA);
            PG8_WAIT_V(8); PG8_WAIT_L(0); PG8_BAR; PG8_MMA(1, 0, At, B0); PG8_MMA(1, 1, At, B1); PG8_BAR; PG8_SCHED;
            } else {
            PG8_LDB(B0, 0, 0); PG8_SCHED; PG8_LDA(At, 0, 0); PG8_STAGE(PG8_SA(1, 1), a1 + hstep, voffA);
            PG8_WAIT_L(8); PG8_BAR; PG8_WAIT_L(0); PG8_MMA(0, 0, At, B0); PG8_BAR; PG8_SCHED;
            PG8_LDB(B1, 0, 1); PG8_STAGE(PG8_SB(0, 0), b2, voffB);
            PG8_BAR; PG8_WAIT_L(0); PG8_MMA(0, 1, At, B1); PG8_BAR;
            PG8_LDA(At, 0, 1); PG8_STAGE(PG8_SA(0, 0), a2, voffA);
            PG8_BAR; PG8_WAIT_L(0); PG8_MMA(1, 0, At, B0); PG8_BAR; PG8_SCHED;
            PG8_STAGE(PG8_SB(0, 1), b2 + hstep, voffB);
            PG8_WAIT_V(6); PG8_BAR; PG8_MMA(1, 1, At, B1); PG8_BAR;
            PG8_LDB(B0, 1, 0); PG8_SCHED; PG8_LDA(At, 1, 0); PG8_STAGE(PG8_SA(0, 1), a2 + hstep, voffA);
            PG8_WAIT_L(8); PG8_BAR; PG8_WAIT_L(0); PG8_MMA(0, 0, At, B0); PG8_BAR; PG8_SCHED;
            PG8_LDB(B1, 1, 1); PG8_STAGE(PG8_SB(1, 0), b3, voffB);
            PG8_BAR; PG8_WAIT_L(0); PG8_MMA(0, 1, At, B1); PG8_BAR;
            PG8_LDA(At, 1, 1); PG8_STAGE(PG8_SA(1, 0), a3, voffA);
            PG8_BAR; PG8_WAIT_L(0); PG8_MMA(1, 0, At, B0); PG8_BAR; PG8_SCHED;
            PG8_STAGE(PG8_SB(1, 1), b3 + hstep, voffB);
            PG8_WAIT_V(6); PG8_BAR; PG8_MMA(1, 1, At, B1); PG8_BAR;
            }
        }
        if constexpr (ALIGN_EPI) { if (wr == 0) PG8_BAR; }
        if constexpr (!Epi::AFTER_DRAIN) { E(acc, cur, wr, wc, fr, fq); S.done(cur); }
        if (!has_next) break;
#pragma unroll
        for (int a = 0; a < 2; ++a)
#pragma unroll
            for (int b = 0; b < 2; ++b)
#pragma unroll
                for (int m = 0; m < 4; ++m)
#pragma unroll
                    for (int n = 0; n < 2; ++n) acc[a][b][m][n] = (f32x4){0.f, 0.f, 0.f, 0.f};
        cur = nxt; cA = nA; cB = nB; ++ui;
        if constexpr (ALIGN_EPI) { if (wr == 1) PG8_BAR; }
    }
    PG8_WAIT_V(0);
    if constexpr (!ALIGN_EPI) { if (wr == 0) PG8_BAR; }
    PG8_BAR;
    if constexpr (Epi::AFTER_DRAIN) { E.fused(acc, cur, wr, wc, fr, fq, lds, wid, lane); S.done(cur); }
#undef PG8_SA
#undef PG8_SB
#undef PG8_STAGE
#undef PG8_LDA
#undef PG8_LDB
#undef PG8_MMA
#undef PG8_WAIT_V
#undef PG8_WAIT_L
#undef PG8_BAR
#undef PG8_SCHED
}
}
#define LAS __attribute__((address_space(3)))
#define XB_TMO      128
#define XB_XCNT(j)  (256  + 64 * (j))
#define XB_XSUB(j)  (1280 + 64 * (j))
#define XB_XGEN(j)  (2304 + 64 * (j))
#define XB_TOP      3328
#define XB_TOPGEN   3392
#define XCD_BAR_WORDS 3456
#define XB_SPIN_CAP (1u << 18)

__device__ __forceinline__ unsigned xb_ld(unsigned* p)              { return __hip_atomic_load(p, __ATOMIC_RELAXED, __HIP_MEMORY_SCOPE_AGENT); }
__device__ __forceinline__ unsigned xb_add(unsigned* p, unsigned v) { return __hip_atomic_fetch_add(p, v, __ATOMIC_RELAXED, __HIP_MEMORY_SCOPE_AGENT); }
__device__ __forceinline__ unsigned xb_xcc_id() { return (unsigned)__builtin_amdgcn_s_getreg((3 << 11) | 20) & 0xFu; }
#define XB_SPIN(cond, bar) do { unsigned _sp = 0; while (cond) { __builtin_amdgcn_s_sleep(1); \
    if ((++_sp & 255u) == 0u) { if (xb_ld(&(bar)[XB_TMO])) break; if (_sp > XB_SPIN_CAP) { atomicAdd(&(bar)[XB_TMO], 1u); break; } } } } while (0)

struct XcdBarrier {
    unsigned* bar; unsigned x;
    volatile LAS unsigned* st;
};

__device__ __forceinline__ XcdBarrier xcd_barrier_post(unsigned* bar, volatile LAS unsigned* st) {
    XcdBarrier b; b.bar = bar; b.x = xb_xcc_id(); b.st = st;
    if (threadIdx.x == 0) (void)xb_add(&bar[XB_XCNT(b.x)], 1u);
    return b;
}
__device__ __forceinline__ void xcd_barrier_complete(unsigned* bar, unsigned x, unsigned& nloc, unsigned& nx) {
    const unsigned G = gridDim.x * gridDim.y * gridDim.z;
    unsigned sum, cnt, mine, sp = 0u;
    for (;;) {
        sum = 0u; cnt = 0u; mine = 0u;
#pragma unroll
        for (unsigned j = 0; j < 16; ++j) { const unsigned c = xb_ld(&bar[XB_XCNT(j)]); sum += c; cnt += (c > 0u) ? 1u : 0u; mine = (j == x) ? c : mine; }
        if (sum == G) break;
        __builtin_amdgcn_s_sleep(1);
        if ((++sp & 255u) == 0u) { if (xb_ld(&bar[XB_TMO])) break; if (sp > XB_SPIN_CAP) { atomicAdd(&bar[XB_TMO], 1u); break; } }
    }
    nloc = mine > 0u ? mine : 1u; nx = cnt > 0u ? cnt : 1u;
}

__device__ __forceinline__ void xcd_barrier(const XcdBarrier& b) {
    asm volatile("s_waitcnt vmcnt(0)" ::: "memory");
    __syncthreads();
    if (threadIdx.x == 0) {
        unsigned* bar = b.bar;
        __builtin_amdgcn_s_waitcnt(0);
        unsigned nloc = b.st[0], nx = b.st[1];
        if (nloc == 0u) { xcd_barrier_complete(bar, b.x, nloc, nx); b.st[0] = nloc; b.st[1] = nx; }
        const unsigned old = xb_add(&bar[XB_XSUB(b.x)], 1u);
        const unsigned gen = old / nloc;
        if (old + 1u == (gen + 1u) * nloc) {
            __builtin_amdgcn_fence(__ATOMIC_RELEASE, "agent");
            asm volatile("s_waitcnt vmcnt(0)" ::: "memory");
            const unsigned og = xb_add(&bar[XB_TOP], 1u);
            const unsigned tg = og / nx;
            if (og + 1u == (tg + 1u) * nx) xb_add(&bar[XB_TOPGEN], 1u);
            else XB_SPIN(xb_ld(&bar[XB_TOPGEN]) == tg, bar);
            __builtin_amdgcn_fence(__ATOMIC_ACQUIRE, "agent");
            xb_add(&bar[XB_XGEN(b.x)], 1u);
            asm volatile("s_waitcnt vmcnt(0)" ::: "memory");
        } else {
            XB_SPIN(xb_ld(&bar[XB_XGEN(b.x)]) == gen, bar);
            __builtin_amdgcn_fence(__ATOMIC_ACQUIRE, "agent");
            asm volatile("s_waitcnt vmcnt(0)" ::: "memory");
        }
    }
    __syncthreads();
}
constexpr int NWAVES = 8;
#ifndef MK_N_LAUNCHES
#define MK_N_LAUNCHES 1
#endif
constexpr int N_PHASES = 7;
constexpr int N_LAUNCHES = MK_N_LAUNCHES;

constexpr int BATCH = 16, SEQ = 2048, D = 1024, M = BATCH * SEQ;
constexpr int CHUNK = 64, NCHUNK = SEQ / CHUNK;
constexpr int D_IN = 3384, NPROJ = 3584;
constexpr int FF = 2816, NGU = 2 * FF;
constexpr float EPS = 1e-6f;
constexpr int NP2 = 2048;
constexpr int C_QI = 0, C_QB = 256, C_KB = 512, C_VB = 768, C_OG = 1280, C_KI = 1792, C_WI = 1824, C_GD = 1832;
__host__ __device__ __forceinline__ int in_src(int r) {
    if (r < 1024) return r;
    if (r < 1280) return 1536 + (r - 1024);
    if (r < 1536) return 1832 + (r - 1280);
    if (r < 1792) return 2088 + (r - 1536);
    if (r < 2304) return 2344 + (r - 1792);
    if (r < 2816) return 2872 + (r - 2304);
    if (r < 2848) return 1792 + (r - 2816);
    if (r < 2856) return 1824 + (r - 2848);
    if (r < 2872) return 2856 + (r - 2856);
    if (r < 3072) return -1;
    return 1024 + (r - 3072);
}
__host__ __device__ __forceinline__ size_t qk_idx(int b, int h, int t, int d) { return (size_t)((b * 8 + h) * 64 + (t >> 5)) * 2048 + (d >> 4) * 512 + (((d >> 3) & 1) * 32 + (t & 31)) * 8 + (d & 7); }
__host__ __device__ __forceinline__ size_t vt_idx(int b, int h, int t, int d) { return (size_t)((b * 8 + h) * 64 + (t >> 5)) * 2048 + (d >> 5) * 1024 + ((t >> 4) & 1) * 512 + (((t >> 2) & 1) * 32 + (d & 31)) * 8 + 4 * ((t >> 3) & 1) + (t & 3); }

constexpr size_t MiB = 1u << 20;
constexpr size_t WS_CTL = 0, CTL_ZERO_BYTES = 1 * MiB;
constexpr size_t WS_WIN = 2 * MiB;
constexpr size_t WS_WOUT = 9 * MiB;
constexpr size_t WS_WGU = 11 * MiB;
constexpr size_t WS_WDN = 22 * MiB;
constexpr size_t WS_RS1 = 28 * MiB;
constexpr size_t WS_RS2 = 30 * MiB;
constexpr size_t WS_H = 40 * MiB;
constexpr size_t WS_QT = 104 * MiB, WS_KT = 136 * MiB, WS_VT = 168 * MiB;
constexpr size_t WS_P2 = 200 * MiB;
constexpr size_t WS_ACT = 104 * MiB;
constexpr size_t WS_MIX = 328 * MiB;
constexpr size_t WS_END = 392 * MiB;
constexpr int CW_BAR = 4096;
constexpr int CW_QUEUE = 64;

constexpr int RING_OFF = 0, RING_BYTES = 131072;
constexpr int BM_OFF = RING_BYTES;
constexpr int TB_OFF = BM_OFF + 64 * 33 * 8;
constexpr int LDSCTL_OFF = TB_OFF + 8192, MISC_OFF = LDSCTL_OFF + 320;
constexpr int LDS_BYTES = LDSCTL_OFF + 1536;
static_assert(LDS_BYTES <= 160 * 1024, "LDS map");

#define GAS __attribute__((address_space(1)))
#ifndef LAS
#define LAS __attribute__((address_space(3)))
#endif
typedef unsigned short bf16;
typedef unsigned v4u __attribute__((ext_vector_type(4)));
typedef unsigned v2u __attribute__((ext_vector_type(2)));
typedef float f32x4 __attribute__((ext_vector_type(4)));
#define LDS_WAIT() asm volatile("s_waitcnt lgkmcnt(0)" ::: "memory")
#define VM_WAIT() asm volatile("s_waitcnt vmcnt(0)" ::: "memory")
__device__ __forceinline__ unsigned f2bf(float f) { unsigned u = __builtin_bit_cast(unsigned, f); return (u + 0x7fffu + ((u >> 16) & 1u)) >> 16; }
__device__ __forceinline__ unsigned pk2(float lo, float hi) { return f2bf(lo) | (f2bf(hi) << 16); }
__device__ __forceinline__ float bf2f(unsigned short b) { return __builtin_bit_cast(float, (unsigned)b << 16); }
__device__ __forceinline__ float bflo(unsigned w) { return __builtin_bit_cast(float, w << 16); }
__device__ __forceinline__ float bfhi(unsigned w) { return __builtin_bit_cast(float, w & 0xffff0000u); }

struct Frame {
    LAS unsigned char* lds;
    volatile LAS unsigned* MISC;
    unsigned* ctl;
    int tid, lane, wave, G;
    const float *x, *norm_mix, *w_in, *w_gate_up, *b_gate, *gla_norm, *w_out, *rel_bias, *norm_ffn, *w_ffn_gate, *w_ffn_up, *w_ffn_down, *norm_final;
    float* out;
    bf16 *WIN, *WOUT, *WGU, *WDN, *H, *QT, *KT, *VT, *P2, *MIX, *ACT;
    float *RS1, *RS2;
};

__device__ __forceinline__ float wave_sum(float v) {
#pragma unroll
    for (int o = 1; o < 64; o <<= 1) v += __shfl_xor(v, o);
    return v;
}
__device__ __forceinline__ float wave_max(float v) {
#pragma unroll
    for (int o = 1; o < 64; o <<= 1) v = fmaxf(v, __shfl_xor(v, o));
    return v;
}
__device__ __forceinline__ int wave_sum_i(int v) {
#pragma unroll
    for (int o = 1; o < 64; o <<= 1) v += __shfl_xor(v, o);
    return v;
}

__device__ __forceinline__ void p0_item(const float* cp, int ld, bf16* WT, int K, int r0, int k0, LAS float* scr, int lane) {
#pragma unroll 8
    for (int i = 0; i < 32; ++i) { const int kk = 2 * i + (lane >> 5); scr[kk * 33 + (lane & 31)] = cp ? cp[(size_t)(k0 + kk) * ld] : 0.f; }
    LDS_WAIT(); asm volatile("" ::: "memory");
    const int c = lane & 7;
#pragma unroll
    for (int j = 0; j < 4; ++j) { const int n = (lane >> 3) + 8 * j; const LAS float* s = scr + (8 * c) * 33 + n;
        v4u o; o.x = pk2(s[0 * 33], s[1 * 33]); o.y = pk2(s[2 * 33], s[3 * 33]); o.z = pk2(s[4 * 33], s[5 * 33]); o.w = pk2(s[6 * 33], s[7 * 33]);
        *(v4u*)(WT + (size_t)(r0 + n) * K + k0 + 8 * c) = o; }
    LDS_WAIT(); asm volatile("" ::: "memory");
}
__device__ __forceinline__ void p0_prologue(Frame& F) {
    LAS float* scr = (LAS float*)(F.lds + RING_OFF + F.wave * 16384);
    const int gw = blockIdx.x * NWAVES + F.wave, NGW = F.G * NWAVES, lane = F.lane;
    constexpr int I_IN = (D / 64) * (NPROJ / 32), I_OUT = (D / 64) * (D / 32), I_GU = (D / 64) * (NGU / 32), I_DN = (FF / 64) * (D / 32);
    constexpr int NITEMS = I_IN + I_OUT + I_GU + I_DN;
    for (int it = gw; it < NITEMS; it += NGW) {
        int r = it;
        if (r < I_IN) { const int kb = r / (NPROJ / 32), nb = r % (NPROJ / 32); const int sc = in_src(32 * nb + (lane & 31));
            p0_item(sc >= 0 ? F.w_in + sc : nullptr, D_IN, F.WIN, D, 32 * nb, 64 * kb, scr, lane); continue; }
        r -= I_IN;
        if (r < I_OUT) { const int kb = r / (D / 32), nb = r % (D / 32);
            p0_item(F.w_out + 32 * nb + (lane & 31), D, F.WOUT, D, 32 * nb, 64 * kb, scr, lane); continue; }
        r -= I_OUT;
        if (r < I_GU) { const int kb = r / (NGU / 32), nb = r % (NGU / 32); const int rr = 32 * nb + (lane & 31), t = rr >> 8, j = rr & 255;
            const float* cp = (j < 128) ? F.w_ffn_gate + 128 * t + j : F.w_ffn_up + 128 * t + (j - 128);
            p0_item(cp, FF, F.WGU, D, 32 * nb, 64 * kb, scr, lane); continue; }
        r -= I_GU;
        { const int kb = r / (D / 32), nb = r % (D / 32);
            p0_item(F.w_ffn_down + 32 * nb + (lane & 31), D, F.WDN, FF, 32 * nb, 64 * kb, scr, lane); }
    }
    for (int m = gw; m < M; m += NGW) {
        const f32x4* xr = (const f32x4*)(F.x + (size_t)m * D) + lane; const f32x4* gr = (const f32x4*)F.norm_mix + lane;
        f32x4 v[4]; float s = 0.f;
#pragma unroll
        for (int j = 0; j < 4; ++j) { v[j] = xr[64 * j]; s += (v[j].x * v[j].x + v[j].y * v[j].y) + (v[j].z * v[j].z + v[j].w * v[j].w); }
        const float r = 1.0f / sqrtf(wave_sum(s) * (1.0f / D) + EPS);
        v2u* o8 = (v2u*)(F.H + (size_t)m * D) + lane;
#pragma unroll
        for (int j = 0; j < 4; ++j) { const f32x4 g = gr[64 * j]; v2u w; w.x = pk2(v[j].x * r * g.x, v[j].y * r * g.y); w.y = pk2(v[j].z * r * g.z, v[j].w * r * g.w); o8[64 * j] = w; }
    }
}

__device__ __forceinline__ int t5_bucket(int rel) {
    const int ret = rel > 0 ? 16 : 0; const int n = rel < 0 ? -rel : rel;
    const int v = n < 8 ? n : n < 12 ? 8 : n < 16 ? 9 : n < 23 ? 10 : n < 32 ? 11 : n < 46 ? 12 : n < 64 ? 13 : n < 91 ? 14 : 15;
    return ret + v;
}
__device__ __forceinline__ unsigned ord_key(float s) { const unsigned b = __builtin_bit_cast(unsigned, s + 0.0f); return (b & 0x80000000u) ? ~b : (b | 0x80000000u); }

__device__ __forceinline__ void dsa_simple(Frame& F) {
    LAS unsigned char* wl = F.lds + RING_OFF + F.wave * 16384;
    LAS float* sc = (LAS float*)wl;
    LAS float* qs = (LAS float*)(wl + 8192);
    LAS float* wq = (LAS float*)(wl + 9216);
    LAS unsigned* list = (LAS unsigned*)(wl + 9472);
    LAS float* pl = (LAS float*)(wl + 10496);
    LAS float* qh = (LAS float*)(wl + 11520);
    const int lane = F.lane, gw = blockIdx.x * NWAVES + F.wave, NGW = F.G * NWAVES;
    const unsigned long long lt = (1ull << lane) - 1ull;
    for (int w = gw; w < M; w += NGW) {
        const int b = w / SEQ, t = ((w % SEQ) + 131 * b) % SEQ, n = t >> 6, L = (n + 1) * CHUNK, nj = n + 1;
        const size_t m = (size_t)b * SEQ + t;
        const bf16* prow = F.P2 + m * NP2;
        { const v2u qv = *(const v2u*)(prow + C_QI + 4 * lane); qs[4 * lane] = bflo(qv.x); qs[4 * lane + 1] = bfhi(qv.x); qs[4 * lane + 2] = bflo(qv.y); qs[4 * lane + 3] = bfhi(qv.y);
          if (lane < 8) wq[lane] = bf2f(prow[C_WI + lane]) * 0.0625f; }
        LDS_WAIT(); asm volatile("" ::: "memory");
        for (int j = 0; j < nj; ++j) {
            const int key = j * 64 + lane; const v4u* kp = (const v4u*)(F.P2 + ((size_t)b * SEQ + key) * NP2 + C_KI);
            float ki[32];
#pragma unroll
            for (int q = 0; q < 4; ++q) { const v4u kv = kp[q]; ki[8 * q] = bflo(kv.x); ki[8 * q + 1] = bfhi(kv.x); ki[8 * q + 2] = bflo(kv.y); ki[8 * q + 3] = bfhi(kv.y);
                ki[8 * q + 4] = bflo(kv.z); ki[8 * q + 5] = bfhi(kv.z); ki[8 * q + 6] = bflo(kv.w); ki[8 * q + 7] = bfhi(kv.w); }
            float s = 0.f;
#pragma unroll 1
            for (int h = 0; h < 8; ++h) { float d = 0.f;
#pragma unroll
                for (int dd = 0; dd < 32; ++dd) d += qs[h * 32 + dd] * ki[dd];
                s += wq[h] * fmaxf(d, 0.f); }
            sc[key] = s;
        }
        LDS_WAIT(); asm volatile("" ::: "memory");
        unsigned selbits = 0u;
        if (L <= 256) selbits = (1u << nj) - 1u;
        else {
            unsigned u[32];
#pragma unroll
            for (int j = 0; j < 32; ++j) u[j] = (j < nj) ? ord_key(sc[j * 64 + lane]) : 0u;
            unsigned T = 0u;
            for (int bit = 31; bit >= 0; --bit) { const unsigned cand = T | (1u << bit); int c = 0;
#pragma unroll
                for (int j = 0; j < 32; ++j) c += (u[j] >= cand) ? 1 : 0;
                c = wave_sum_i(c); if (c >= 256) T = cand; }
            int cg = 0;
#pragma unroll
            for (int j = 0; j < 32; ++j) cg += (u[j] > T) ? 1 : 0;
            cg = wave_sum_i(cg); const int r = 256 - cg; int run = 0;
#pragma unroll
            for (int j = 0; j < 32; ++j) { const bool eq = (u[j] == T); const unsigned long long em = __ballot(eq); const int pre = run + __popcll(em & lt);
                if ((u[j] > T) || (eq && pre < r)) selbits |= (1u << j); run += __popcll(em); }
        }
        int nsel = 0;
#pragma unroll
        for (int j = 0; j < 32; ++j) { const bool s = (selbits >> j) & 1u; const unsigned long long mk = __ballot(s); if (s) list[nsel + __popcll(mk & lt)] = (unsigned)(j * 64 + lane); nsel += __popcll(mk); }
        LDS_WAIT(); asm volatile("" ::: "memory");
        for (int h = 0; h < 8; ++h) {
            qh[lane] = bf2f(F.QT[qk_idx(b, h, t, lane)]);
            LDS_WAIT(); asm volatile("" ::: "memory");
            float lg[4]; float mx = -1e30f;
#pragma unroll
            for (int c = 0; c < 4; ++c) { const int idx = c * 64 + lane; lg[c] = -1e30f;
                if (idx < nsel) { const int key = (int)list[idx]; float d = 0.f;
#pragma unroll
                    for (int q = 0; q < 8; ++q) { const v4u kv = *(const v4u*)(F.KT + qk_idx(b, h, key, 8 * q)); d += qh[8 * q] * bflo(kv.x) + qh[8 * q + 1] * bfhi(kv.x) + qh[8 * q + 2] * bflo(kv.y) + qh[8 * q + 3] * bfhi(kv.y)
                        + qh[8 * q + 4] * bflo(kv.z) + qh[8 * q + 5] * bfhi(kv.z) + qh[8 * q + 6] * bflo(kv.w) + qh[8 * q + 7] * bfhi(kv.w); }
                    lg[c] = d + F.rel_bias[t5_bucket(key - t) * 8 + h]; }
                mx = fmaxf(mx, lg[c]); }
            mx = wave_max(mx); float sum = 0.f;
#pragma unroll
            for (int c = 0; c < 4; ++c) { const int idx = c * 64 + lane; lg[c] = (idx < nsel) ? __expf(lg[c] - mx) : 0.f; sum += lg[c]; }
            sum = wave_sum(sum); const float inv = 1.0f / sum;
#pragma unroll
            for (int c = 0; c < 4; ++c) pl[c * 64 + lane] = lg[c] * inv;
            LDS_WAIT(); asm volatile("" ::: "memory");
            float o = 0.f;
            for (int i = 0; i < nsel; ++i) { const int key = (int)list[i]; o += pl[i] * bf2f(F.VT[vt_idx(b, h, key, lane)]); }
            F.MIX[m * D + h * 64 + lane] = (bf16)f2bf(o);
            LDS_WAIT(); asm volatile("" ::: "memory");
        }
    }
}


typedef short bf16x8 __attribute__((ext_vector_type(8)));
typedef float f32x16 __attribute__((ext_vector_type(16)));
__device__ __forceinline__ bf16x8 pack8(float a0, float a1, float a2, float a3, float a4, float a5, float a6, float a7) {
    typedef __bf16 b2 __attribute__((ext_vector_type(2))); typedef float f2 __attribute__((ext_vector_type(2)));
    v4u r;
    r.x = __builtin_bit_cast(unsigned, __builtin_convertvector((f2){a0, a1}, b2)); r.y = __builtin_bit_cast(unsigned, __builtin_convertvector((f2){a2, a3}, b2));
    r.z = __builtin_bit_cast(unsigned, __builtin_convertvector((f2){a4, a5}, b2)); r.w = __builtin_bit_cast(unsigned, __builtin_convertvector((f2){a6, a7}, b2));
    return __builtin_bit_cast(bf16x8, r);
}
__device__ __forceinline__ void dsa_bias_table(Frame& F) {
    LAS float* tb = (LAS float*)(F.lds + TB_OFF);
    for (int e = F.tid; e < 2048; e += NWAVES * 64) { const int h = e >> 8, i = e & 255; tb[e] = (i < 255) ? F.rel_bias[t5_bucket(i - 191) * 8 + h] - F.rel_bias[15 * 8 + h] : 0.f; }
}
#define DSA_FOR_J(...) do { _Pragma("unroll") for (int j = 0; j < 8; ++j) { __VA_ARGS__ } \
    if (nk > 8) { _Pragma("unroll") for (int j = 8; j < 16; ++j) { __VA_ARGS__ } } \
    if (nk > 16) { _Pragma("unroll") for (int j = 16; j < 24; ++j) { __VA_ARGS__ } } \
    if (nk > 24) { _Pragma("unroll") for (int j = 24; j < 32; ++j) { __VA_ARGS__ } } } while (0)
__device__ __forceinline__ void dsa_select(Frame& F, int b, int n) {
    const int lane = F.lane, wave = F.wave, tid = F.tid, L = (n + 1) * CHUNK, nk = n + 1;
    LAS float* sc = (LAS float*)(F.lds + RING_OFF);
    LAS unsigned long long* bm = (LAS unsigned long long*)(F.lds + BM_OFF);
    const size_t tokb = (size_t)b * SEQ;
    if (nk <= 4) { for (int e = tid; e < 64 * nk; e += NWAVES * 64) bm[(e / nk) * 33 + (e % nk)] = ~0ull; return; }
    const int fr = lane & 15, fq = lane >> 4;
    const int ntl = (4 * nk - wave + 7) >> 3;
    for (int sb = 0; sb < 4; ++sb) {
        const int q0 = 64 * n + 16 * sb;
        {
            bf16x8 qf[8];
#pragma unroll
            for (int h = 0; h < 8; ++h) qf[h] = *(const bf16x8*)(F.P2 + (tokb + q0 + fr) * NP2 + C_QI + h * 32 + 8 * fq);
            float wv[4][8];
#pragma unroll
            for (int r = 0; r < 4; ++r) { const v4u w = *(const v4u*)(F.P2 + (tokb + q0 + 4 * fq + r) * NP2 + C_WI);
                wv[r][0] = bflo(w.x) * 0.0625f; wv[r][1] = bfhi(w.x) * 0.0625f; wv[r][2] = bflo(w.y) * 0.0625f; wv[r][3] = bfhi(w.y) * 0.0625f;
                wv[r][4] = bflo(w.z) * 0.0625f; wv[r][5] = bfhi(w.z) * 0.0625f; wv[r][6] = bflo(w.w) * 0.0625f; wv[r][7] = bfhi(w.w) * 0.0625f; }
#pragma unroll 2
            for (int i = 0; i < ntl; ++i) {
                const int key = 16 * (wave + 8 * i) + fr;
                const bf16x8 kf = *(const bf16x8*)(F.P2 + (tokb + key) * NP2 + C_KI + 8 * fq);
                f32x4 s = {0.f, 0.f, 0.f, 0.f};
#pragma unroll
                for (int h = 0; h < 8; ++h) { const f32x4 d = __builtin_amdgcn_mfma_f32_16x16x32_bf16(qf[h], kf, (f32x4){0.f, 0.f, 0.f, 0.f}, 0, 0, 0);
#pragma unroll
                    for (int r = 0; r < 4; ++r) s[r] += wv[r][h] * fmaxf(d[r], 0.f); }
#pragma unroll
                for (int r = 0; r < 4; ++r) { const int q = 4 * fq + r; sc[q * L + (key ^ (((q >> 2) & 1) << 4))] = s[r] + 0.0f; }
            }
        }
        __syncthreads();
#pragma unroll 1
        for (int which = 0; which < 2; ++which) {
            const int ql = 2 * wave + which, sw = ((ql >> 2) & 1) << 4;
            unsigned u[32];
#pragma unroll
            for (int j = 0; j < 32; ++j) u[j] = 0u;
            DSA_FOR_J( u[j] = (j < nk) ? ord_key(sc[ql * L + ((j * 64 + lane) ^ sw)]) : 0u; );
            unsigned T = 0u;
            for (int bit = 31; bit >= 0; --bit) {
                const unsigned cand = T | (1u << bit); int na = 0;
                DSA_FOR_J( na += __popcll(__ballot(u[j] >= cand)); );
                if (na >= 256) T = cand;
                if (na == 256) break;
            }
            int cg = 0;
            DSA_FOR_J( cg += __popcll(__ballot(u[j] > T)); );
            int r = 256 - cg;
            LAS unsigned long long* bmq = bm + (16 * sb + ql) * 33;
            DSA_FOR_J( { const unsigned long long mgt = __ballot(u[j] > T); unsigned long long meq = __ballot(u[j] == T); int ne = __popcll(meq);
                if (ne > r) { unsigned long long keep = 0ull, t2 = meq; for (int c = 0; c < r; ++c) { const unsigned long long low = t2 & (~t2 + 1ull); keep |= low; t2 ^= low; } meq = keep; ne = r; }
                r -= ne;
                if (lane == 0) bmq[j] = mgt | meq; } );
        }
        __syncthreads();
    }
}
__device__ __forceinline__ void dsa_attend(Frame& F, int b, int n) {
    const int lane = F.lane, h = F.wave, nk = n + 1, qq = lane & 31, hh = lane >> 5;
    const LAS unsigned* bm32 = (const LAS unsigned*)(F.lds + BM_OFF);
    const LAS float* tbw = (const LAS float*)(F.lds + TB_OFF) + h * 256;
    const size_t hb = (size_t)((b * 8 + h) * 64) * 2048;
    const bf16* Qb = F.QT + hb; const bf16* Kb = F.KT + hb; const bf16* Vb = F.VT + hb;
    constexpr float LOG2E = 1.44269504f;
    bf16x8 qf[2][4];
#pragma unroll
    for (int qt = 0; qt < 2; ++qt)
#pragma unroll
        for (int ks = 0; ks < 4; ++ks) qf[qt][ks] = *(const bf16x8*)(Qb + (size_t)(2 * n + qt) * 2048 + ks * 512 + lane * 8);
    f32x16 o[2][2];
#pragma unroll
    for (int dt = 0; dt < 2; ++dt)
#pragma unroll
        for (int qt = 0; qt < 2; ++qt)
#pragma unroll
            for (int i = 0; i < 16; ++i) o[dt][qt][i] = 0.f;
    float mrow[2] = {-1e30f, -1e30f}, lsum[2] = {0.f, 0.f};
    for (int j2 = 0; j2 < 2 * nk; ++j2) {
        bf16x8 kfr[4], vfr[2][2];
#pragma unroll
        for (int ks = 0; ks < 4; ++ks) kfr[ks] = *(const bf16x8*)(Kb + (size_t)j2 * 2048 + ks * 512 + lane * 8);
#pragma unroll
        for (int dt = 0; dt < 2; ++dt)
#pragma unroll
            for (int s = 0; s < 2; ++s) vfr[dt][s] = *(const bf16x8*)(Vb + (size_t)j2 * 2048 + dt * 1024 + s * 512 + lane * 8);
        const bool near = ((j2 >> 1) >= n - 2);
#pragma unroll
        for (int qt = 0; qt < 2; ++qt) {
            f32x16 st;
#pragma unroll
            for (int i = 0; i < 16; ++i) st[i] = 0.f;
#pragma unroll
            for (int ks = 0; ks < 4; ++ks) st = __builtin_amdgcn_mfma_f32_32x32x16_bf16(kfr[ks], qf[qt][ks], st, 0, 0, 0);
            const unsigned ww = bm32[(32 * qt + qq) * 66 + j2] >> (4 * hh);
            const int tbase = 32 * j2 - 64 * n - 32 * qt + 4 * hh - qq + 191;
            float mx = -1e30f;
#pragma unroll
            for (int i = 0; i < 16; ++i) { const int bit = (i & 3) + 8 * (i >> 2);
                float sv = st[i];
                if (near) sv += tbw[tbase + bit];
                const unsigned msk = (unsigned)__builtin_amdgcn_sbfe((int)ww, bit, 1);
                sv = __builtin_bit_cast(float, (__builtin_bit_cast(unsigned, sv) & msk) | (0xff800000u & ~msk));
                st[i] = sv; mx = fmaxf(mx, sv); }
            mx = fmaxf(mx, __shfl_xor(mx, 32));
            const float mnew = fmaxf(mrow[qt], mx), alpha = __builtin_amdgcn_exp2f((mrow[qt] - mnew) * LOG2E), mb = mnew * LOG2E;
            mrow[qt] = mnew;
            float ps = 0.f;
#pragma unroll
            for (int i = 0; i < 16; ++i) { const float p = __builtin_amdgcn_exp2f(st[i] * LOG2E - mb); st[i] = p; ps += p; }
            lsum[qt] = lsum[qt] * alpha + ps;
#pragma unroll
            for (int dt = 0; dt < 2; ++dt)
#pragma unroll
                for (int i = 0; i < 16; ++i) o[dt][qt][i] *= alpha;
#pragma unroll
            for (int s = 0; s < 2; ++s) {
                const bf16x8 pf = pack8(st[8 * s], st[8 * s + 1], st[8 * s + 2], st[8 * s + 3], st[8 * s + 4], st[8 * s + 5], st[8 * s + 6], st[8 * s + 7]);
#pragma unroll
                for (int dt = 0; dt < 2; ++dt) o[dt][qt] = __builtin_amdgcn_mfma_f32_32x32x16_bf16(vfr[dt][s], pf, o[dt][qt], 0, 0, 0);
            }
        }
    }
#pragma unroll
    for (int qt = 0; qt < 2; ++qt) {
        const float l = lsum[qt] + __shfl_xor(lsum[qt], 32), inv = 1.0f / l;
        bf16* orow = F.MIX + ((size_t)b * SEQ + 64 * n + 32 * qt + qq) * D + h * 64;
#pragma unroll
        for (int dt = 0; dt < 2; ++dt)
#pragma unroll
            for (int g = 0; g < 4; ++g) { v2u w; w.x = pk2(o[dt][qt][4 * g] * inv, o[dt][qt][4 * g + 1] * inv); w.y = pk2(o[dt][qt][4 * g + 2] * inv, o[dt][qt][4 * g + 3] * inv);
                *(v2u*)(orow + 32 * dt + 8 * g + 4 * hh) = w; }
    }
}
__device__ __forceinline__ void dsa_fast(Frame& F) {
    dsa_bias_table(F);
    __syncthreads();
    for (;;) {
        if (F.tid == 0) F.MISC[16] = atomicAdd(F.ctl + CW_QUEUE, 1u);
        __syncthreads();
        const unsigned id = F.MISC[16];
        if (id >= (unsigned)(BATCH * NCHUNK)) break;
        const int n = NCHUNK - 1 - (int)(id >> 4), b = (int)(id & 15);
        dsa_select(F, b, n);
        __syncthreads();
        dsa_attend(F, b, n);
        __syncthreads();
    }
}


constexpr int GS = 72;
constexpr int G_QIN = 0, G_KIN = G_QIN + 64 * GS * 2, G_KINT = G_KIN + 64 * GS * 2, G_VT = G_KINT + 64 * GS * 2, G_ST = G_VT + 128 * GS * 2;
constexpr int G_WG = G_ST + 2 * 128 * GS * 2, G_BG = G_WG + 16 * 64 * 4, G_EBL = G_BG + 256, G_PP = G_EBL + 256, G_END = G_PP + 2 * 4 * 64 * 4;
static_assert(G_END <= RING_BYTES, "GLA LDS map");
typedef short bf16x4 __attribute__((ext_vector_type(4)));
__device__ __forceinline__ float wave_incl_scan(float v, int lane) {
#pragma unroll
    for (int o = 1; o < 64; o <<= 1) { const float t = __shfl_up(v, o); if (lane >= o) v += t; }
    return v;
}
__device__ __forceinline__ bf16x8 cat44(bf16x4 a, bf16x4 b) { return (bf16x8){a[0], a[1], a[2], a[3], b[0], b[1], b[2], b[3]}; }
__device__ __forceinline__ void gla_fast(Frame& F) {
    const int tid = F.tid, lane = F.lane, w = F.wave, vt = w >> 1, tt = w & 1, ql = lane & 31, hh = lane >> 5;
    LAS bf16* qin = (LAS bf16*)(F.lds + G_QIN); LAS bf16* kin = (LAS bf16*)(F.lds + G_KIN); LAS bf16* kinT = (LAS bf16*)(F.lds + G_KINT); LAS bf16* vT = (LAS bf16*)(F.lds + G_VT);
    LAS bf16* ST = (LAS bf16*)(F.lds + G_ST); LAS float* Wg = (LAS float*)(F.lds + G_WG); LAS float* bg = (LAS float*)(F.lds + G_BG); LAS float* ebl = (LAS float*)(F.lds + G_EBL); LAS float* pp = (LAS float*)(F.lds + G_PP);
    for (int unit = blockIdx.x; unit < BATCH * 4; unit += F.G) {
        const int b = unit >> 2, h = unit & 3;
        __syncthreads();
        for (int e = tid; e < 1024; e += NWAVES * 64) Wg[e] = F.w_gate_up[(e >> 6) * 256 + h * 64 + (e & 63)];
        if (tid < 64) bg[tid] = F.b_gate[h * 64 + tid];
        for (int e = tid; e < 128 * GS; e += NWAVES * 64) ST[e] = 0;
        f32x16 sacc;
#pragma unroll
        for (int i = 0; i < 16; ++i) sacc[i] = 0.f;
        f32x4 gain[4];
#pragma unroll
        for (int g = 0; g < 4; ++g) gain[g] = *(const f32x4*)(F.gla_norm + h * 128 + 32 * vt + 8 * g + 4 * hh);
        __syncthreads();
        for (int n = 0; n < NCHUNK; ++n) {
            const size_t tok0 = (size_t)b * SEQ + n * CHUNK;
            LAS bf16* STc = ST + (n & 1) * 128 * GS; LAS bf16* STn = ST + ((n + 1) & 1) * 128 * GS; LAS float* ppc = pp + (n & 1) * 256;
            {
                const bf16* prow = F.P2 + (tok0 + lane) * NP2;
                const v4u g0 = *(const v4u*)(prow + C_GD), g1 = *(const v4u*)(prow + C_GD + 8);
                const v4u qv = *(const v4u*)(prow + C_QB + h * 64 + 8 * w), kv = *(const v4u*)(prow + C_KB + h * 64 + 8 * w);
                const v4u v0 = *(const v4u*)(prow + C_VB + h * 128 + 16 * w), v1 = *(const v4u*)(prow + C_VB + h * 128 + 16 * w + 8);
                float gdv[16];
                gdv[0] = bflo(g0.x); gdv[1] = bfhi(g0.x); gdv[2] = bflo(g0.y); gdv[3] = bfhi(g0.y); gdv[4] = bflo(g0.z); gdv[5] = bfhi(g0.z); gdv[6] = bflo(g0.w); gdv[7] = bfhi(g0.w);
                gdv[8] = bflo(g1.x); gdv[9] = bfhi(g1.x); gdv[10] = bflo(g1.y); gdv[11] = bfhi(g1.y); gdv[12] = bflo(g1.z); gdv[13] = bfhi(g1.z); gdv[14] = bflo(g1.w); gdv[15] = bfhi(g1.w);
                float xg[8];
                { const f32x4 ba = *(const LAS f32x4*)(bg + 8 * w), bb = *(const LAS f32x4*)(bg + 8 * w + 4);
                  xg[0] = ba[0]; xg[1] = ba[1]; xg[2] = ba[2]; xg[3] = ba[3]; xg[4] = bb[0]; xg[5] = bb[1]; xg[6] = bb[2]; xg[7] = bb[3]; }
#pragma unroll 2
                for (int r = 0; r < 16; ++r) { const f32x4 wa = *(const LAS f32x4*)(Wg + r * 64 + 8 * w), wb = *(const LAS f32x4*)(Wg + r * 64 + 8 * w + 4);
                    xg[0] += gdv[r] * wa[0]; xg[1] += gdv[r] * wa[1]; xg[2] += gdv[r] * wa[2]; xg[3] += gdv[r] * wa[3]; xg[4] += gdv[r] * wb[0]; xg[5] += gdv[r] * wb[1]; xg[6] += gdv[r] * wb[2]; xg[7] += gdv[r] * wb[3]; }
                float qf_[8], kf_[8];
                qf_[0] = bflo(qv.x); qf_[1] = bfhi(qv.x); qf_[2] = bflo(qv.y); qf_[3] = bfhi(qv.y); qf_[4] = bflo(qv.z); qf_[5] = bfhi(qv.z); qf_[6] = bflo(qv.w); qf_[7] = bfhi(qv.w);
                kf_[0] = bflo(kv.x); kf_[1] = bfhi(kv.x); kf_[2] = bflo(kv.y); kf_[3] = bfhi(kv.y); kf_[4] = bflo(kv.z); kf_[5] = bfhi(kv.z); kf_[6] = bflo(kv.w); kf_[7] = bfhi(kv.w);
                float qo[8], ko[8];
#pragma unroll
                for (int i = 0; i < 8; ++i) {
                    const float la = (fminf(xg[i], 0.f) - log1pf(__expf(-fabsf(xg[i])))) * (1.0f / 16.0f);
                    const float bc = wave_incl_scan(la, lane);
                    const float eb = __expf(bc), enb = __expf(-bc);
                    qo[i] = qf_[i] * 0.125f * eb; ko[i] = kf_[i] * enb;
                    if (lane == 63) ebl[8 * w + i] = eb;
                    kinT[(8 * w + i) * GS + lane] = (bf16)f2bf(ko[i]);
                }
                *(LAS bf16x8*)(qin + lane * GS + 8 * w) = pack8(qo[0], qo[1], qo[2], qo[3], qo[4], qo[5], qo[6], qo[7]);
                *(LAS bf16x8*)(kin + lane * GS + 8 * w) = pack8(ko[0], ko[1], ko[2], ko[3], ko[4], ko[5], ko[6], ko[7]);
                const unsigned vw[8] = {v0.x, v0.y, v0.z, v0.w, v1.x, v1.y, v1.z, v1.w};
#pragma unroll
                for (int e = 0; e < 8; ++e) { vT[(16 * w + 2 * e) * GS + lane] = (bf16)(vw[e] & 0xffffu); vT[(16 * w + 2 * e + 1) * GS + lane] = (bf16)(vw[e] >> 16); }
            }
            __syncthreads();
            f32x16 acc;
#pragma unroll
            for (int i = 0; i < 16; ++i) acc[i] = 0.f;
            bf16x8 qB[4];
#pragma unroll
            for (int ks = 0; ks < 4; ++ks) qB[ks] = *(const LAS bf16x8*)(qin + (32 * tt + ql) * GS + 16 * ks + 8 * hh);
#pragma unroll
            for (int ks = 0; ks < 4; ++ks) { const bf16x8 sA = *(const LAS bf16x8*)(STc + (32 * vt + ql) * GS + 16 * ks + 8 * hh); acc = __builtin_amdgcn_mfma_f32_32x32x16_bf16(sA, qB[ks], acc, 0, 0, 0); }
            bf16x8 vA[2][2];
#pragma unroll
            for (int st = 0; st < 2; ++st)
#pragma unroll
                for (int s2 = 0; s2 < 2; ++s2) { const LAS bf16* vp = vT + (32 * vt + ql) * GS + 32 * st + 16 * s2 + 4 * hh; vA[st][s2] = cat44(*(const LAS bf16x4*)vp, *(const LAS bf16x4*)(vp + 8)); }
#pragma unroll
            for (int st = 0; st < 2; ++st) if (st <= tt) {
                f32x16 X;
#pragma unroll
                for (int i = 0; i < 16; ++i) X[i] = 0.f;
#pragma unroll
                for (int ks = 0; ks < 4; ++ks) { const bf16x8 kA = *(const LAS bf16x8*)(kin + (32 * st + ql) * GS + 16 * ks + 8 * hh); X = __builtin_amdgcn_mfma_f32_32x32x16_bf16(kA, qB[ks], X, 0, 0, 0); }
                if (st == tt) {
#pragma unroll
                    for (int i = 0; i < 16; ++i) { const int sl = (i & 3) + 8 * (i >> 2) + 4 * hh; X[i] = (sl > ql) ? 0.f : X[i]; }
                }
#pragma unroll
                for (int s2 = 0; s2 < 2; ++s2) {
                    const bf16x8 pf = pack8(X[8 * s2], X[8 * s2 + 1], X[8 * s2 + 2], X[8 * s2 + 3], X[8 * s2 + 4], X[8 * s2 + 5], X[8 * s2 + 6], X[8 * s2 + 7]);
                    acc = __builtin_amdgcn_mfma_f32_32x32x16_bf16(vA[st][s2], pf, acc, 0, 0, 0);
                }
            }
#pragma unroll
            for (int st = 0; st < 2; ++st)
#pragma unroll
                for (int s2 = 0; s2 < 2; ++s2) { const LAS bf16* kp = kinT + (32 * tt + ql) * GS + 32 * st + 16 * s2 + 4 * hh; const bf16x8 kB = cat44(*(const LAS bf16x4*)kp, *(const LAS bf16x4*)(kp + 8));
                    sacc = __builtin_amdgcn_mfma_f32_32x32x16_bf16(vA[st][s2], kB, sacc, 0, 0, 0); }
            { const float eb = ebl[32 * tt + ql];
#pragma unroll
              for (int i = 0; i < 16; ++i) { sacc[i] *= eb; STn[(32 * vt + (i & 3) + 8 * (i >> 2) + 4 * hh) * GS + 32 * tt + ql] = (bf16)f2bf(sacc[i]); } }
            float ss = 0.f;
#pragma unroll
            for (int i = 0; i < 16; ++i) ss += acc[i] * acc[i];
            ss += __shfl_xor(ss, 32);
            if (hh == 0) ppc[vt * 64 + 32 * tt + ql] = ss;
            __syncthreads();
            { const int tl = 32 * tt + ql; const float tot = (ppc[tl] + ppc[64 + tl]) + (ppc[128 + tl] + ppc[192 + tl]);
              const float rr = 1.0f / sqrtf(tot * (1.0f / 128.0f) + EPS);
              const bf16* og = F.P2 + (tok0 + tl) * NP2 + C_OG + h * 128 + 32 * vt + 4 * hh; bf16* orow = F.MIX + (tok0 + tl) * D + 512 + h * 128 + 32 * vt + 4 * hh;
#pragma unroll
              for (int g = 0; g < 4; ++g) { const v2u gw = *(const v2u*)(og + 8 * g); const float z0 = bflo(gw.x), z1 = bfhi(gw.x), z2 = bflo(gw.y), z3 = bfhi(gw.y);
                  const float y0 = acc[4 * g] * rr * gain[g][0] * (z0 / (1.0f + __expf(-z0))), y1 = acc[4 * g + 1] * rr * gain[g][1] * (z1 / (1.0f + __expf(-z1)));
                  const float y2 = acc[4 * g + 2] * rr * gain[g][2] * (z2 / (1.0f + __expf(-z2))), y3 = acc[4 * g + 3] * rr * gain[g][3] * (z3 / (1.0f + __expf(-z3)));
                  v2u ow; ow.x = pk2(y0, y1); ow.y = pk2(y2, y3); *(v2u*)(orow + 8 * g) = ow; } }
        }
    }
}

__device__ __forceinline__ void gla_simple(Frame& F) {
    LAS float* qin = (LAS float*)(F.lds + RING_OFF);
    LAS float* kin = qin + 64 * 65;
    LAS float* att = kin + 64 * 65;
    LAS float* vv = att + 64 * 65;
    LAS float* S = vv + 64 * 128;
    LAS float* gd = S + 64 * 128;
    LAS float* Wg = gd + 64 * 16;
    LAS float* bg = Wg + 16 * 64;
    LAS float* ebl = bg + 64;
    const int tid = F.tid, lane = F.lane, wave = F.wave;
    for (int unit = blockIdx.x; unit < BATCH * 4; unit += F.G) {
        const int b = unit >> 2, h = unit & 3;
        for (int e = tid; e < 1024; e += 512) Wg[e] = F.w_gate_up[(e >> 6) * 256 + h * 64 + (e & 63)];
        if (tid < 64) bg[tid] = F.b_gate[h * 64 + tid];
        for (int e = tid; e < 8192; e += 512) S[e] = 0.f;
        __syncthreads();
        for (int n = 0; n < NCHUNK; ++n) {
            const size_t tok0 = (size_t)b * SEQ + n * CHUNK;
            for (int e = tid; e < 1024; e += 512) gd[e] = bf2f(F.P2[(tok0 + (e >> 4)) * NP2 + C_GD + (e & 15)]);
            __syncthreads();
            for (int e = tid; e < 4096; e += 512) { const int t = e >> 6, d = e & 63; float xg = bg[d];
#pragma unroll
                for (int r = 0; r < 16; ++r) xg += gd[t * 16 + r] * Wg[r * 64 + d];
                att[t * 65 + d] = (fminf(xg, 0.f) - log1pf(__expf(-fabsf(xg)))) * (1.0f / 16.0f); }
            __syncthreads();
            if (tid < 64) { float run = 0.f; for (int t = 0; t < 64; ++t) { run += att[t * 65 + tid]; att[t * 65 + tid] = run; } ebl[tid] = __expf(run); }
            __syncthreads();
            for (int e = tid; e < 4096; e += 512) { const int t = e >> 6, d = e & 63; const float bc = att[t * 65 + d];
                const float q = bf2f(F.P2[(tok0 + t) * NP2 + C_QB + h * 64 + d]), k = bf2f(F.P2[(tok0 + t) * NP2 + C_KB + h * 64 + d]);
                qin[t * 65 + d] = q * 0.125f * __expf(bc); kin[t * 65 + d] = k * __expf(-bc); }
            for (int e = tid; e < 8192; e += 512) vv[e] = bf2f(F.P2[(tok0 + (e >> 7)) * NP2 + C_VB + h * 128 + (e & 127)]);
            __syncthreads();
            for (int e = tid; e < 4096; e += 512) { const int t = e >> 6, s = e & 63; float a = 0.f;
                if (s <= t) {
#pragma unroll 8
                    for (int d = 0; d < 64; ++d) a += qin[t * 65 + d] * kin[s * 65 + d]; }
                att[t * 65 + s] = a; }
            __syncthreads();
            const int v = tid & 127, q4 = tid >> 7; float o[16];
#pragma unroll
            for (int i = 0; i < 16; ++i) { const int t = q4 * 16 + i; float a = 0.f;
                for (int s = 0; s <= t; ++s) a += att[t * 65 + s] * vv[s * 128 + v];
#pragma unroll 8
                for (int d = 0; d < 64; ++d) a += qin[t * 65 + d] * S[d * 128 + v];
                o[i] = a; }
            __syncthreads();
#pragma unroll 1
            for (int i = 0; i < 16; ++i) { const int d = q4 * 16 + i; float a = 0.f;
#pragma unroll 8
                for (int s = 0; s < 64; ++s) a += kin[s * 65 + d] * vv[s * 128 + v];
                S[d * 128 + v] = ebl[d] * (S[d * 128 + v] + a); }
            __syncthreads();
#pragma unroll
            for (int i = 0; i < 16; ++i) vv[(q4 * 16 + i) * 128 + v] = o[i];
            __syncthreads();
            for (int r = 0; r < 8; ++r) { const int t = wave * 8 + r; const float x0 = vv[t * 128 + lane], x1 = vv[t * 128 + 64 + lane];
                const float rr = 1.0f / sqrtf(wave_sum(x0 * x0 + x1 * x1) * (1.0f / 128.0f) + EPS);
                const float g0 = bf2f(F.P2[(tok0 + t) * NP2 + C_OG + h * 128 + lane]), g1 = bf2f(F.P2[(tok0 + t) * NP2 + C_OG + h * 128 + 64 + lane]);
                const float y0 = x0 * rr * F.gla_norm[h * 128 + lane] * (g0 / (1.0f + __expf(-g0))), y1 = x1 * rr * F.gla_norm[h * 128 + 64 + lane] * (g1 / (1.0f + __expf(-g1)));
                F.MIX[(tok0 + t) * D + 512 + h * 128 + lane] = (bf16)f2bf(y0); F.MIX[(tok0 + t) * D + 512 + h * 128 + 64 + lane] = (bf16)f2bf(y1); }
            __syncthreads();
        }
    }
}

__device__ __forceinline__ void p6_final(Frame& F) {
    const int gw = blockIdx.x * NWAVES + F.wave, NGW = F.G * NWAVES, lane = F.lane;
    for (int m = gw; m < M; m += NGW) {
        const f32x4* rp = (const f32x4*)(F.RS2 + (size_t)m * 16); const f32x4 p0 = rp[0], p1 = rp[1], p2 = rp[2], p3 = rp[3];
        const float ssq = ((p0[0] + p0[1]) + (p0[2] + p0[3])) + ((p1[0] + p1[1]) + (p1[2] + p1[3])) + ((p2[0] + p2[1]) + (p2[2] + p2[3])) + ((p3[0] + p3[1]) + (p3[2] + p3[3]));
        const float r = 1.0f / sqrtf(ssq * (1.0f / D) + EPS);
        f32x4* xr = (f32x4*)(F.out + (size_t)m * D) + lane; const f32x4* gr = (const f32x4*)F.norm_final + lane;
#pragma unroll
        for (int j = 0; j < 4; ++j) { const f32x4 v = xr[64 * j], g = gr[64 * j]; xr[64 * j] = v * r * g; }
    }
}

struct Args { const float* in[13]; float* out; unsigned char* ws; int ph_lo, ph_hi; };
__global__ void __launch_bounds__(NWAVES * 64, 2) fwd(Args args) {
    extern __shared__ __attribute__((aligned(16))) unsigned char lds[];
    Frame F;
    F.lds = (LAS unsigned char*)lds;
    F.MISC = (volatile LAS unsigned*)(F.lds + MISC_OFF);
    F.tid = threadIdx.x; F.lane = F.tid & 63; F.wave = __builtin_amdgcn_readfirstlane(F.tid >> 6);
    F.G = gridDim.x;
    unsigned char* ws = args.ws;
    F.ctl = (unsigned*)(ws + WS_CTL);
    F.x = args.in[0]; F.norm_mix = args.in[1]; F.w_in = args.in[2]; F.w_gate_up = args.in[3]; F.b_gate = args.in[4]; F.gla_norm = args.in[5]; F.w_out = args.in[6]; F.rel_bias = args.in[7];
    F.norm_ffn = args.in[8]; F.w_ffn_gate = args.in[9]; F.w_ffn_up = args.in[10]; F.w_ffn_down = args.in[11]; F.norm_final = args.in[12]; F.out = args.out;
    F.WIN = (bf16*)(ws + WS_WIN); F.WOUT = (bf16*)(ws + WS_WOUT); F.WGU = (bf16*)(ws + WS_WGU); F.WDN = (bf16*)(ws + WS_WDN);
    F.H = (bf16*)(ws + WS_H); F.QT = (bf16*)(ws + WS_QT); F.KT = (bf16*)(ws + WS_KT); F.VT = (bf16*)(ws + WS_VT); F.P2 = (bf16*)(ws + WS_P2); F.MIX = (bf16*)(ws + WS_MIX); F.ACT = (bf16*)(ws + WS_ACT);
    F.RS1 = (float*)(ws + WS_RS1); F.RS2 = (float*)(ws + WS_RS2);
    for (int u = F.tid; u < (LDS_BYTES - LDSCTL_OFF) / 4; u += NWAVES * 64) ((LAS unsigned*)(F.lds + LDSCTL_OFF))[u] = 0u;
    __syncthreads();
    XcdBarrier bar; bar.bar = F.ctl + CW_BAR; bar.x = 0; bar.st = nullptr;
    if (N_LAUNCHES == 1) bar = xcd_barrier_post(F.ctl + CW_BAR, F.MISC + 8);
    const int lo = args.ph_lo, hi = args.ph_hi;
#define IN(k) (lo <= (k) && (k) < hi)
#define SEAM(k) do { if (IN(k) && IN((k) + 1)) xcd_barrier(bar); } while (0)

    if (IN(0)) { p0_prologue(F); }
    SEAM(0);
    if (IN(1)) {
        { pg8::Gemm g{F.H, F.WIN, M, 3072, D}; pg8::StaticOrder S; S.init(M, 3072, F.G, (int)blockIdx.x);
          pg8::EpiProjA E{F.QT, F.KT, F.P2};
          pg8::gemm_phase<pg8::EpiProjA, pg8::StaticOrder, true, true, false>(F.lds + RING_OFF, g, S, E); }
        { pg8::Gemm g{F.H, F.WIN + (size_t)3072 * D, M, 512, D}; pg8::StaticOrder S; S.init(M, 512, F.G, (int)blockIdx.x);
          pg8::EpiVT E{F.VT};
          pg8::gemm_phase<pg8::EpiVT, pg8::StaticOrder, true, true, true>(F.lds + RING_OFF, g, S, E); }
    }
    SEAM(1);
    if (IN(2)) { gla_fast(F); __syncthreads(); dsa_fast(F); }
    SEAM(2);
    if (IN(3)) {
        pg8::Gemm g{F.MIX, F.WOUT, M, D, D}; pg8::StaticOrder S; S.init(M, D, F.G, (int)blockIdx.x);
        pg8::EpiOut E{F.x, F.out, F.H, F.norm_ffn, F.RS1};
        pg8::gemm_phase<pg8::EpiOut, pg8::StaticOrder, true, true>(F.lds + RING_OFF, g, S, E);
    }
    SEAM(3);
    if (IN(4)) {
        pg8::Gemm g{F.H, F.WGU, M, NGU, D}; pg8::StaticOrder S; S.init(M, NGU, F.G, (int)blockIdx.x);
        pg8::EpiGU E{F.RS1, F.ACT, EPS};
        pg8::gemm_phase<pg8::EpiGU, pg8::StaticOrder, true, true>(F.lds + RING_OFF, g, S, E);
    }
    SEAM(4);
    if (IN(5)) {
        pg8::Gemm g{F.ACT, F.WDN, M, D, FF}; pg8::StaticOrder S; S.init(M, D, F.G, (int)blockIdx.x);
        pg8::EpiDown E{F.out, F.RS2};
        pg8::gemm_phase<pg8::EpiDown, pg8::StaticOrder, true, true>(F.lds + RING_OFF, g, S, E);
    }
    SEAM(5);
    if (IN(6)) { p6_final(F); }
#undef IN
#undef SEAM
}

extern "C" void kernel_launch(void* const* d_in, const int* in_sizes, int n_in, void* d_out, int out_size, void* d_ws, size_t ws_size, hipStream_t stream) {
    static int grid = 0;
    if (grid == 0) {
        if (n_in != 13 || in_sizes[0] != M * D || out_size != M * D || ws_size < WS_END) { fprintf(stderr, "kernel_launch: unexpected shapes (n_in %d, in0 %d, out %d, ws %zu)\n", n_in, n_in > 0 ? in_sizes[0] : -1, out_size, ws_size); grid = -1; return; }
        int dev = 0, cus = 0, per_cu = 0;
        if (hipGetDevice(&dev) != hipSuccess || hipDeviceGetAttribute(&cus, hipDeviceAttributeMultiprocessorCount, dev) != hipSuccess) { grid = -1; return; }
        if (hipFuncSetAttribute((const void*)fwd, hipFuncAttributeMaxDynamicSharedMemorySize, LDS_BYTES) != hipSuccess) { fprintf(stderr, "kernel_launch: hipFuncSetAttribute failed\n"); grid = -1; return; }
        if (hipOccupancyMaxActiveBlocksPerMultiprocessor(&per_cu, (const void*)fwd, NWAVES * 64, LDS_BYTES) != hipSuccess || per_cu < 1) fprintf(stderr, "kernel_launch: occupancy query reports %d\n", per_cu);
        (void)hipGetLastError();
        grid = cus;
    }
    if (grid < 0) return;
    (void)hipMemsetAsync((char*)d_ws + WS_CTL, 0, CTL_ZERO_BYTES, stream);
    Args a{};
    for (int i = 0; i < 13; ++i) a.in[i] = (const float*)d_in[i];
    a.out = (float*)d_out; a.ws = (unsigned char*)d_ws;
    if (N_LAUNCHES == 1) { a.ph_lo = 0; a.ph_hi = N_PHASES; hipLaunchKernelGGL(fwd, dim3(grid), dim3(NWAVES * 64), LDS_BYTES, stream, a); }
    else for (int p = 0; p < N_PHASES; ++p) { a.ph_lo = p; a.ph_hi = p + 1; hipLaunchKernelGGL(fwd, dim3(grid), dim3(NWAVES * 64), LDS_BYTES, stream, a); }
}
```

```cpp
#include <hip/hip_runtime.h>
#include <cstdio>
#include <cstdint>
namespace pg8 {
#define PG8_LAS __attribute__((address_space(3)))
typedef unsigned short bf16_t;
typedef short bf16x8 __attribute__((ext_vector_type(8)));
typedef float f32x4 __attribute__((ext_vector_type(4)));
typedef unsigned u32x4 __attribute__((ext_vector_type(4)));
constexpr int BM = 256, BK = 64, HALF = 128, HTB = HALF * BK * 2  , STAGE_BYTES = 8 * HTB, NXCD = 8, WGM = 8;

__host__ __device__ __forceinline__ int lds_byte(int r, int c) { const int st = (r >> 4) * 2 + (c >> 5), rr = r & 15, cc = c & 31, ob = rr * 64 + cc * 2; return st * 1024 + (ob ^ (((ob >> 9) & 1) << 5)); }
__host__ __device__ __forceinline__ void stage_rc(int b, int& R, int& C) { const int st = b / 1024, sb = b % 1024, swz = sb ^ (((sb >> 9) & 1) << 5); R = (st >> 1) * 16 + swz / 64; C = (st & 1) * 32 + (swz % 64) / 2; }
__host__ __device__ __forceinline__ int perm32(int rho) { const int n = rho >> 4, i = rho & 15; return 8 * (i >> 2) + 4 * n + (i & 3); }

struct Unit { int pm, pn; };
struct Gemm { const bf16_t* A; const bf16_t* Bt; int M, N, K; };

struct StaticOrder {
    int nM, nN, nwg, G, c;
    __host__ __device__ void init(int M, int N, int G_, int c_) { nM = M / BM; nN = N / BM; nwg = nM * nN; G = G_; c = c_; }
    __host__ __device__ bool next(int i, Unit& u) const {
        const long L = (long)i * G + c; if (L >= nwg) return false;
        int wgid = (int)L; { const int q = nwg / NXCD, r = nwg % NXCD, xcd = wgid % NXCD, off = wgid / NXCD; wgid = (xcd < r ? xcd * (q + 1) : r * (q + 1) + (xcd - r) * q) + off; }
        const int nig = WGM * nN, gid = wgid / nig, fm = gid * WGM, gsz = (nM - fm) < WGM ? (nM - fm) : WGM;
        u.pm = fm + ((wgid % nig) % gsz); u.pn = (wgid % nig) / gsz; return true;
    }
    __device__ __forceinline__ void a_ready(const Unit&) const {}
    __device__ __forceinline__ void done(const Unit&) const {}
};

__device__ __forceinline__ unsigned cvt_pk_bf16(float lo, float hi) { unsigned r; asm volatile("v_cvt_pk_bf16_f32 %0, %1, %2" : "=v"(r) : "v"(lo), "v"(hi)); return r; }
typedef float f32x2 __attribute__((ext_vector_type(2)));
__device__ __forceinline__ f32x2 gelu_pk(f32x2 v) {
    const f32x2 av = __builtin_elementwise_abs(v), d = av * 0.2316418882f + 1.0f;
    f32x2 t; t.x = __builtin_amdgcn_rcpf(d.x); t.y = __builtin_amdgcn_rcpf(d.y);
    f32x2 q = t * 0.5307027145f + (-0.7265760135f); q = q * t + 0.7107068705f; q = q * t + (-0.142248368f); q = q * t + 0.127414796f; q = q * t;
    const f32x2 s = (v * v) * (-0.72134752044f);
    f32x2 e; e.x = __builtin_amdgcn_exp2f(s.x); e.y = __builtin_amdgcn_exp2f(s.y);
    const f32x2 m = v * (q * e), r = v - m;
    f32x2 o; o.x = v.x < 0.f ? m.x : r.x; o.y = v.y < 0.f ? m.y : r.y; return o;
}

template <int ACT  > struct EpiBf16 {
    static constexpr bool PERM = true, AFTER_DRAIN = false; static_assert(ACT == 0 || ACT == 1, "EpiBf16: ACT is 0 (none) or 1 (gelu_pk)");
    bf16_t* O; int ldc; const float* bias; int split_cols; size_t split_stride; float scale0;
    __device__ __forceinline__ void operator()(const f32x4 (&acc)[2][2][4][2], const Unit& u, int wr, int wc, int fr, int fq) const {
        const int row0 = u.pm * BM + wr * 64 + fr; int colt = u.pn * BM; bf16_t* base = O;
        float sc = 1.f; if (split_cols) { const int t = colt / split_cols; base += (size_t)t * split_stride; colt -= t * split_cols; if (t == 0) sc = scale0; }
        const int col0 = colt + wc * 32 + 8 * fq, bcol0 = u.pn * BM + wc * 32 + 8 * fq;
        f32x4 bv[2][2];
#pragma unroll
        for (int bj = 0; bj < 2; ++bj)
#pragma unroll
            for (int n = 0; n < 2; ++n) bv[bj][n] = bias ? *(const f32x4*)(bias + bcol0 + bj * HALF + 4 * n) : (f32x4){0.f, 0.f, 0.f, 0.f};
#pragma unroll
        for (int ai = 0; ai < 2; ++ai)
#pragma unroll
            for (int m = 0; m < 4; ++m) { bf16_t* rowp = base + (size_t)(row0 + ai * HALF + m * 16) * ldc + col0;
#pragma unroll
                for (int bj = 0; bj < 2; ++bj) { f32x4 v0 = acc[ai][bj][m][0] + bv[bj][0], v1 = acc[ai][bj][m][1] + bv[bj][1];
                    if (ACT == 1) { f32x2 a = gelu_pk((f32x2){v0[0], v0[1]}), b = gelu_pk((f32x2){v0[2], v0[3]}), c = gelu_pk((f32x2){v1[0], v1[1]}), d = gelu_pk((f32x2){v1[2], v1[3]});
                        v0 = (f32x4){a.x, a.y, b.x, b.y}; v1 = (f32x4){c.x, c.y, d.x, d.y}; }
                    v0 = v0 * sc; v1 = v1 * sc; u32x4 w; w.x = cvt_pk_bf16(v0[0], v0[1]); w.y = cvt_pk_bf16(v0[2], v0[3]); w.z = cvt_pk_bf16(v1[0], v1[1]); w.w = cvt_pk_bf16(v1[2], v1[3]);
                    *(u32x4*)(rowp + bj * HALF) = w; } }
    }
};
struct EpiOut {
    static constexpr bool PERM = true, AFTER_DRAIN = false;
    const float* x; float* x1; bf16_t* hn; const float* g; float* rs;
    __device__ __forceinline__ void operator()(const f32x4 (&acc)[2][2][4][2], const Unit& u, int wr, int wc, int fr, int fq) const {
        const int row0 = u.pm * BM + wr * 64 + fr, col0 = u.pn * BM + wc * 32 + 8 * fq;
        f32x4 gv[2][2];
#pragma unroll
        for (int bj = 0; bj < 2; ++bj)
#pragma unroll
            for (int n = 0; n < 2; ++n) gv[bj][n] = *(const f32x4*)(g + col0 + bj * HALF + 4 * n);
#pragma unroll
        for (int ai = 0; ai < 2; ++ai)
#pragma unroll
            for (int m = 0; m < 4; ++m) { const int row = row0 + ai * HALF + m * 16; const size_t off = (size_t)row * 1024 + col0; float ss = 0.f;
#pragma unroll
                for (int bj = 0; bj < 2; ++bj) {
                    const f32x4 xa = *(const f32x4*)(x + off + bj * HALF), xb = *(const f32x4*)(x + off + bj * HALF + 4);
                    const f32x4 v0 = acc[ai][bj][m][0] + xa, v1 = acc[ai][bj][m][1] + xb;
                    *(f32x4*)(x1 + off + bj * HALF) = v0; *(f32x4*)(x1 + off + bj * HALF + 4) = v1;
                    ss += (v0[0] * v0[0] + v0[1] * v0[1]) + (v0[2] * v0[2] + v0[3] * v0[3]) + (v1[0] * v1[0] + v1[1] * v1[1]) + (v1[2] * v1[2] + v1[3] * v1[3]);
                    const f32x4 h0 = v0 * gv[bj][0], h1 = v1 * gv[bj][1];
                    u32x4 w; w.x = cvt_pk_bf16(h0[0], h0[1]); w.y = cvt_pk_bf16(h0[2], h0[3]); w.z = cvt_pk_bf16(h1[0], h1[1]); w.w = cvt_pk_bf16(h1[2], h1[3]);
                    *(u32x4*)(hn + off + bj * HALF) = w; }
                ss += __shfl_xor(ss, 16); ss += __shfl_xor(ss, 32);
                if (fq == 0) rs[(size_t)row * 16 + u.pn * 4 + wc] = ss; }
    }
};
struct EpiGU {
    static constexpr bool PERM = true, AFTER_DRAIN = false;
    const float* rs; bf16_t* act; float eps;
    __device__ __forceinline__ void operator()(const f32x4 (&acc)[2][2][4][2], const Unit& u, int wr, int wc, int fr, int fq) const {
        const int row0 = u.pm * BM + wr * 64 + fr, col0 = u.pn * HALF + wc * 32 + 8 * fq;
#pragma unroll
        for (int ai = 0; ai < 2; ++ai)
#pragma unroll
            for (int m = 0; m < 4; ++m) { const int row = row0 + ai * HALF + m * 16;
                const f32x4* rp = (const f32x4*)(rs + (size_t)row * 16); const f32x4 p0 = rp[0], p1 = rp[1], p2 = rp[2], p3 = rp[3];
                const float ssq = ((p0[0] + p0[1]) + (p0[2] + p0[3])) + ((p1[0] + p1[1]) + (p1[2] + p1[3])) + ((p2[0] + p2[1]) + (p2[2] + p2[3])) + ((p3[0] + p3[1]) + (p3[2] + p3[3]));
                const float r = 1.0f / sqrtf(ssq * (1.0f / 1024.0f) + eps);
                float a[8];
#pragma unroll
                for (int n = 0; n < 2; ++n)
#pragma unroll
                    for (int j = 0; j < 4; ++j) { const float gg = acc[ai][0][m][n][j] * r, uu = acc[ai][1][m][n][j] * r;
                        a[4 * n + j] = gg * __builtin_amdgcn_rcpf(1.0f + __builtin_amdgcn_exp2f(gg * -1.44269504f)) * uu; }
                u32x4 w; w.x = cvt_pk_bf16(a[0], a[1]); w.y = cvt_pk_bf16(a[2], a[3]); w.z = cvt_pk_bf16(a[4], a[5]); w.w = cvt_pk_bf16(a[6], a[7]);
                *(u32x4*)(act + (size_t)row * 2816 + col0) = w; }
    }
};
struct EpiDown {
    static constexpr bool PERM = true, AFTER_DRAIN = false;
    float* xio; float* rs;
    __device__ __forceinline__ void operator()(const f32x4 (&acc)[2][2][4][2], const Unit& u, int wr, int wc, int fr, int fq) const {
        const int row0 = u.pm * BM + wr * 64 + fr, col0 = u.pn * BM + wc * 32 + 8 * fq;
#pragma unroll
        for (int ai = 0; ai < 2; ++ai)
#pragma unroll
            for (int m = 0; m < 4; ++m) { const int row = row0 + ai * HALF + m * 16; const size_t off = (size_t)row * 1024 + col0; float ss = 0.f;
#pragma unroll
                for (int bj = 0; bj < 2; ++bj) {
                    const f32x4 xa = *(const f32x4*)(xio + off + bj * HALF), xb = *(const f32x4*)(xio + off + bj * HALF + 4);
                    const f32x4 v0 = acc[ai][bj][m][0] + xa, v1 = acc[ai][bj][m][1] + xb;
                    *(f32x4*)(xio + off + bj * HALF) = v0; *(f32x4*)(xio + off + bj * HALF + 4) = v1;
                    ss += (v0[0] * v0[0] + v0[1] * v0[1]) + (v0[2] * v0[2] + v0[3] * v0[3]) + (v1[0] * v1[0] + v1[1] * v1[1]) + (v1[2] * v1[2] + v1[3] * v1[3]); }
                ss += __shfl_xor(ss, 16); ss += __shfl_xor(ss, 32);
                if (fq == 0) rs[(size_t)row * 16 + u.pn * 4 + wc] = ss; }
    }
};
struct EpiProjA {
    static constexpr bool PERM = true, AFTER_DRAIN = false;
    bf16_t* QT; bf16_t* KT; bf16_t* P2;
    __device__ __forceinline__ void operator()(const f32x4 (&acc)[2][2][4][2], const Unit& u, int wr, int wc, int fr, int fq) const {
        const int row0 = u.pm * BM + wr * 64 + fr;
        if (u.pn < 4) {
            bf16_t* dst = (u.pn < 2) ? QT : KT; const float sc = (u.pn < 2) ? 0.18033688f : 1.0f;
#pragma unroll
            for (int bj = 0; bj < 2; ++bj) { const int c = (u.pn & 1) * BM + bj * HALF + wc * 32 + 8 * fq, h = c >> 6, p = (c & 63) >> 3;
#pragma unroll
                for (int ai = 0; ai < 2; ++ai)
#pragma unroll
                    for (int m = 0; m < 4; ++m) { const int row = row0 + ai * HALF + m * 16, b = row >> 11, t = row & 2047;
                        const f32x4 v0 = acc[ai][bj][m][0] * sc, v1 = acc[ai][bj][m][1] * sc;
                        u32x4 w; w.x = cvt_pk_bf16(v0[0], v0[1]); w.y = cvt_pk_bf16(v0[2], v0[3]); w.z = cvt_pk_bf16(v1[0], v1[1]); w.w = cvt_pk_bf16(v1[2], v1[3]);
                        *(u32x4*)(dst + ((size_t)((b * 8 + h) * 64 + (t >> 5)) * 2048 + (p >> 1) * 512 + ((p & 1) * 32 + (t & 31)) * 8)) = w; } }
        } else {
            const int col0 = (u.pn - 4) * BM + wc * 32 + 8 * fq;
#pragma unroll
            for (int ai = 0; ai < 2; ++ai)
#pragma unroll
                for (int m = 0; m < 4; ++m) { bf16_t* rowp = P2 + (size_t)(row0 + ai * HALF + m * 16) * 2048 + col0;
#pragma unroll
                    for (int bj = 0; bj < 2; ++bj) { const f32x4 v0 = acc[ai][bj][m][0], v1 = acc[ai][bj][m][1];
                        u32x4 w; w.x = cvt_pk_bf16(v0[0], v0[1]); w.y = cvt_pk_bf16(v0[2], v0[3]); w.z = cvt_pk_bf16(v1[0], v1[1]); w.w = cvt_pk_bf16(v1[2], v1[3]);
                        *(u32x4*)(rowp + bj * HALF) = w; } }
        }
    }
};
struct EpiVT {
    static constexpr bool PERM = false, AFTER_DRAIN = false;
    bf16_t* VT;
    __device__ __forceinline__ void operator()(const f32x4 (&acc)[2][2][4][2], const Unit& u, int wr, int wc, int fr, int fq) const {
#pragma unroll
        for (int bj = 0; bj < 2; ++bj)
#pragma unroll
            for (int n = 0; n < 2; ++n) { const int c = u.pn * BM + bj * HALF + wc * 32 + 16 * n + fr, h = c >> 6, d = c & 63;
#pragma unroll
                for (int ai = 0; ai < 2; ++ai)
#pragma unroll
                    for (int m = 0; m < 4; ++m) { const int row = u.pm * BM + ai * HALF + wr * 64 + m * 16 + 4 * fq, b = row >> 11, t = row & 2047;
                        const f32x4 v = acc[ai][bj][m][n];
                        unsigned lo = cvt_pk_bf16(v[0], v[1]), hi = cvt_pk_bf16(v[2], v[3]);
                        typedef unsigned u32x2 __attribute__((ext_vector_type(2)));
                        u32x2 w; w.x = lo; w.y = hi;
                        *(u32x2*)(VT + ((size_t)((b * 8 + h) * 64 + (t >> 5)) * 2048 + (d >> 5) * 1024 + ((t >> 4) & 1) * 512 + ((((t >> 2) & 1) * 32) + (d & 31)) * 8 + 4 * ((t >> 3) & 1))) = w; } }
    }
};
template <class Epi, class Sched, bool ALIGN_EPI = false, bool SP2 = false, bool SWAP = false>
__device__ __forceinline__ void gemm_phase(PG8_LAS unsigned char* lds, const Gemm g, const Sched& S, const Epi& E) {
    const int tid = threadIdx.x, wid = __builtin_amdgcn_readfirstlane(tid >> 6), lane = tid & 63, wr = wid >> 2, wc = wid & 3, fr = lane & 15, fq = lane >> 4;
    const int K = g.K, nt = K / BK;
    unsigned voffA[2], voffB[2];
#pragma unroll
    for (int i = 0; i < 2; ++i) { int R, C; stage_rc(tid * 16 + i * 8192, R, C); const int Rb = Epi::PERM ? ((R & ~31) + perm32(R & 31)) : R;
        voffA[i] = (unsigned)(R * K + C) * 2u; voffB[i] = (unsigned)(Rb * K + C) * 2u; }
    const size_t kstep = (size_t)(BK * 2);
    const size_t hstep = (size_t)HALF * K * 2;
    const size_t tstep = 2 * hstep;
    const unsigned ldsw = (unsigned)wid * 1024u;
    const int aoff = lds_byte(wr * 64 + fr, fq * 8), boff = lds_byte(wc * 32 + fr, fq * 8);
#define PG8_SA(b, h) (((b) * 2 + (h)) * HTB)
#define PG8_SB(b, h) ((4 + (b) * 2 + (h)) * HTB)
#define PG8_STAGE(bufoff, gbase, voff) do { _Pragma("unroll") for (int _i = 0; _i < 2; ++_i) \
        __builtin_amdgcn_global_load_lds((const unsigned*)((const char*)(gbase) + (voff)[_i]), (PG8_LAS unsigned*)(lds + (bufoff) + ldsw + _i * 8192), 16, 0, 0); } while (0)
#define PG8_LDA(dst, b, h) do { _Pragma("unroll") for (int m = 0; m < 4; ++m) _Pragma("unroll") for (int k = 0; k < 2; ++k) dst[m][k] = *(const PG8_LAS bf16x8*)(lds + PG8_SA(b, h) + aoff + m * 2048 + k * 1024); } while (0)
#define PG8_LDB(dst, b, h) do { _Pragma("unroll") for (int n = 0; n < 2; ++n) _Pragma("unroll") for (int k = 0; k < 2; ++k) dst[n][k] = *(const PG8_LAS bf16x8*)(lds + PG8_SB(b, h) + boff + n * 2048 + k * 1024); } while (0)
#define PG8_MMA(ai, bj, At, Bt) do { __builtin_amdgcn_s_setprio(1); _Pragma("unroll") for (int m = 0; m < 4; ++m) _Pragma("unroll") for (int n = 0; n < 2; ++n) _Pragma("unroll") for (int k = 0; k < 2; ++k) \
        { if constexpr (SWAP) acc[ai][bj][m][n] = __builtin_amdgcn_mfma_f32_16x16x32_bf16(At[m][k], Bt[n][k], acc[ai][bj][m][n], 0, 0, 0); else acc[ai][bj][m][n] = __builtin_amdgcn_mfma_f32_16x16x32_bf16(Bt[n][k], At[m][k], acc[ai][bj][m][n], 0, 0, 0); } __builtin_amdgcn_s_setprio(0); } while (0)
#define PG8_WAIT_V(n) asm volatile("s_waitcnt vmcnt(" #n ")" ::: "memory")
#define PG8_WAIT_L(n) asm volatile("s_waitcnt lgkmcnt(" #n ")" ::: "memory")
#define PG8_BAR __builtin_amdgcn_s_barrier()
#define PG8_SCHED __builtin_amdgcn_sched_barrier(0)
    Unit cur, nxt; int ui = 0;
    if (!S.next(0, cur)) return;
    f32x4 acc[2][2][4][2];
#pragma unroll
    for (int a = 0; a < 2; ++a)
#pragma unroll
        for (int b = 0; b < 2; ++b)
#pragma unroll
            for (int m = 0; m < 4; ++m)
#pragma unroll
                for (int n = 0; n < 2; ++n) acc[a][b][m][n] = (f32x4){0.f, 0.f, 0.f, 0.f};
    bf16x8 At[4][2], B0[2][2], B1[2][2];
    const char* cA = (const char*)g.A + (size_t)cur.pm * tstep; const char* cB = (const char*)g.Bt + (size_t)cur.pn * tstep;
    S.a_ready(cur);
    if constexpr (SP2) {
        PG8_STAGE(PG8_SB(0, 0), cB, voffB); PG8_STAGE(PG8_SB(0, 1), cB + hstep, voffB); PG8_STAGE(PG8_SA(0, 0), cA, voffA); PG8_STAGE(PG8_SA(0, 1), cA + hstep, voffA);
        if (wr == 1) PG8_BAR;
        PG8_WAIT_V(2); PG8_BAR;
        PG8_STAGE(PG8_SB(1, 0), cB + kstep, voffB); PG8_STAGE(PG8_SA(1, 0), cA + kstep, voffA); PG8_STAGE(PG8_SB(1, 1), cB + hstep + kstep, voffB);
        PG8_WAIT_V(6); PG8_BAR;
    } else {
        PG8_STAGE(PG8_SB(0, 0), cB, voffB); PG8_STAGE(PG8_SA(0, 0), cA, voffA); PG8_STAGE(PG8_SB(0, 1), cB + hstep, voffB); PG8_STAGE(PG8_SA(0, 1), cA + hstep, voffA);
        if (wr == 1) PG8_BAR;
        PG8_WAIT_V(4); PG8_BAR;
        PG8_STAGE(PG8_SB(1, 0), cB + kstep, voffB); PG8_STAGE(PG8_SA(1, 0), cA + kstep, voffA); PG8_STAGE(PG8_SB(1, 1), cB + hstep + kstep, voffB);
        PG8_WAIT_V(6); PG8_BAR;
    }
    for (;;) {
        const bool has_next = S.next(ui + 1, nxt);
        const char* nA = has_next ? (const char*)g.A + (size_t)nxt.pm * tstep : cA; const char* nB = has_next ? (const char*)g.Bt + (size_t)nxt.pn * tstep : cB;
        for (int t = 0; t < nt; t += 2) {
            const bool last = (t == nt - 2);
            const char* a1 = cA + (size_t)(t + 1) * kstep;
            const char* a2 = last ? nA : cA + (size_t)(t + 2) * kstep; const char* b2 = last ? nB : cB + (size_t)(t + 2) * kstep;
            const char* a3 = a2 + kstep; const char* b3 = b2 + kstep;
            if (last && has_next) S.a_ready(nxt);
            if constexpr (SP2) {
            PG8_LDB(B0, 0, 0); PG8_LDB(B1, 0, 1); PG8_SCHED; PG8_LDA(At, 0, 0); PG8_STAGE(PG8_SA(1, 1), a1 + hstep, voffA);
            PG8_WAIT_V(8); PG8_WAIT_L(0); PG8_BAR; PG8_MMA(0, 0, At, B0); PG8_MMA(0, 1, At, B1); PG8_BAR; PG8_SCHED;
            PG8_LDA(At, 0, 1); PG8_STAGE(PG8_SB(0, 0), b2, voffB); PG8_STAGE(PG8_SB(0, 1), b2 + hstep, voffB); PG8_STAGE(PG8_SA(0, 0), a2, voffA);
            PG8_WAIT_V(8); PG8_WAIT_L(0); PG8_BAR; PG8_MMA(1, 0, At, B0); PG8_MMA(1, 1, At, B1); PG8_BAR; PG8_SCHED;
            PG8_LDB(B0, 1, 0); PG8_LDB(B1, 1, 1); PG8_SCHED; PG8_LDA(At, 1, 0); PG8_STAGE(PG8_SA(0, 1), a2 + hstep, voffA);
            PG8_WAIT_V(8); PG8_WAIT_L(0); PG8_BAR; PG8_MMA(0, 0, At, B0); PG8_MMA(0, 1, At, B1); PG8_BAR; PG8_SCHED;
            PG8_LDA(At, 1, 1); PG8_STAGE(PG8_SB(1, 0), b3, voffB); PG8_STAGE(PG8_SB(1, 1), b3 + hstep, voffB); PG8_STAGE(PG8_SA(1, 0), a3, voffA);
            PG8_WAIT_V(8); PG8_WAIT_L(0); PG8_BAR; PG8_MMA(1, 0, At, B0); PG8_MMA(1, 1, At, B1); PG8_BAR; PG8_SCHED;
            } else {
            PG8_LDB(B0, 0, 0); PG8_SCHED; PG8_LDA(At, 0, 0); PG8_STAGE(PG8_SA(1, 1), a1 + hstep, voffA);
            PG8_WAIT_L(8); PG8_BAR; PG8_WAIT_L(0); PG8_MMA(0, 0, At, B0); PG8_BAR; PG8_SCHED;
            PG8_LDB(B1, 0, 1); PG8_STAGE(PG8_SB(0, 0), b2, voffB);
            PG8_BAR; PG8_WAIT_L(0); PG8_MMA(0, 1, At, B1); PG8_BAR;
            PG8_LDA(At, 0, 1); PG8_STAGE(PG8_SA(0, 0), a2, voffA);
            PG8_BAR; PG8_WAIT_L(0); PG8_MMA(1, 0, At, B0); PG8_BAR; PG8_SCHED;
            PG8_STAGE(PG8_SB(0, 1), b2 + hstep, voffB);
            PG8_WAIT_V(6); PG8_BAR; PG8_MMA(1, 1, At, B1); PG8_BAR;
            PG8_LDB(B0, 1, 0); PG8_SCHED; PG8_LDA(At, 1, 0); PG8_STAGE(PG8_SA(0, 1), a2 + hstep, voffA);
            PG8_WAIT_L(8); PG8_BAR; PG8_WAIT_L(0); PG8_MMA(0, 0, At, B0); PG8_BAR; PG8_SCHED;
            PG8_LDB(B1, 1, 1); PG8_STAGE(PG8_SB(1, 0), b3, voffB);
            PG8_BAR; PG8_WAIT_L(0); PG8_MMA(0, 1, At, B1); PG8_BAR;
            PG8_LDA(At, 1, 1); PG8_STAGE(PG8_SA(1, 0), a3, voffA);
            PG8_BAR; PG8_WAIT_L(0); PG8_MMA(1, 0, At, B0); PG8_BAR; PG8_SCHED;
            PG8_STAGE(PG8_SB(1, 1), b3 + hstep, voffB);
            PG8_WAIT_V(6); PG8_BAR; PG8_MMA(1, 1, At, B1); PG8_BAR;
            }
        }
        if constexpr (ALIGN_EPI) { if (wr == 0) PG8_BAR; }
        if constexpr (!Epi::AFTER_DRAIN) { E(acc, cur, wr, wc, fr, fq); S.done(cur); }
        if (!has_next) break;
#pragma unroll
        for (int a = 0; a < 2; ++a)
#pragma unroll
            for (int b = 0; b < 2; ++b)
#pragma unroll
                for (int m = 0; m < 4; ++m)
#pragma unroll
                    for (int n = 0; n < 2; ++n) acc[a][b][m][n] = (f32x4){0.f, 0.f, 0.f, 0.f};
        cur = nxt; cA = nA; cB = nB; ++ui;
        if constexpr (ALIGN_EPI) { if (wr == 1) PG8_BAR; }
    }
    PG8_WAIT_V(0);
    if constexpr (!ALIGN_EPI) { if (wr == 0) PG8_BAR; }
    PG8_BAR;
    if constexpr (Epi::AFTER_DRAIN) { E.fused(acc, cur, wr, wc, fr, fq, lds, wid, lane); S.done(cur); }
#undef PG8_SA
#undef PG8_SB
#undef PG8_STAGE
#undef PG8_LDA
#undef PG8_LDB
#undef PG8_MMA
#undef PG8_WAIT_V
#undef PG8_WAIT_L
#undef PG8_BAR
#undef PG8_SCHED
}
}
#define LAS __attribute__((address_space(3)))
#define XB_TMO      128
#define XB_XCNT(j)  (256  + 64 * (j))
#define XB_XSUB(j)  (1280 + 64 * (j))
#define XB_XGEN(j)  (2304 + 64 * (j))
#define XB_TOP      3328
#define XB_TOPGEN   3392
#define XCD_BAR_WORDS 3456
#define XB_SPIN_CAP (1u << 18)

__device__ __forceinline__ unsigned xb_ld(unsigned* p)              { return __hip_atomic_load(p, __ATOMIC_RELAXED, __HIP_MEMORY_SCOPE_AGENT); }
__device__ __forceinline__ unsigned xb_add(unsigned* p, unsigned v) { return __hip_atomic_fetch_add(p, v, __ATOMIC_RELAXED, __HIP_MEMORY_SCOPE_AGENT); }
__device__ __forceinline__ unsigned xb_xcc_id() { return (unsigned)__builtin_amdgcn_s_getreg((3 << 11) | 20) & 0xFu; }
#define XB_SPIN(cond, bar) do { unsigned _sp = 0; while (cond) { __builtin_amdgcn_s_sleep(1); \
    if ((++_sp & 255u) == 0u) { if (xb_ld(&(bar)[XB_TMO])) break; if (_sp > XB_SPIN_CAP) { atomicAdd(&(bar)[XB_TMO], 1u); break; } } } } while (0)

struct XcdBarrier {
    unsigned* bar; unsigned x;
    volatile LAS unsigned* st;
};

__device__ __forceinline__ XcdBarrier xcd_barrier_post(unsigned* bar, volatile LAS unsigned* st) {
    XcdBarrier b; b.bar = bar; b.x = xb_xcc_id(); b.st = st;
    if (threadIdx.x == 0) (void)xb_add(&bar[XB_XCNT(b.x)], 1u);
    return b;
}
__device__ __forceinline__ void xcd_barrier_complete(unsigned* bar, unsigned x, unsigned& nloc, unsigned& nx) {
    const unsigned G = gridDim.x * gridDim.y * gridDim.z;
    unsigned sum, cnt, mine, sp = 0u;
    for (;;) {
        sum = 0u; cnt = 0u; mine = 0u;
#pragma unroll
        for (unsigned j = 0; j < 16; ++j) { const unsigned c = xb_ld(&bar[XB_XCNT(j)]); sum += c; cnt += (c > 0u) ? 1u : 0u; mine = (j == x) ? c : mine; }
        if (sum == G) break;
        __builtin_amdgcn_s_sleep(1);
        if ((++sp & 255u) == 0u) { if (xb_ld(&bar[XB_TMO])) break; if (sp > XB_SPIN_CAP) { atomicAdd(&bar[XB_TMO], 1u); break; } }
    }
    nloc = mine > 0u ? mine : 1u; nx = cnt > 0u ? cnt : 1u;
}

__device__ __forceinline__ void xcd_barrier(const XcdBarrier& b) {
    asm volatile("s_waitcnt vmcnt(0)" ::: "memory");
    __syncthreads();
    if (threadIdx.x == 0) {
        unsigned* bar = b.bar;
        __builtin_amdgcn_s_waitcnt(0);
        unsigned nloc = b.st[0], nx = b.st[1];
        if (nloc == 0u) { xcd_barrier_complete(bar, b.x, nloc, nx); b.st[0] = nloc; b.st[1] = nx; }
        const unsigned old = xb_add(&bar[XB_XSUB(b.x)], 1u);
        const unsigned gen = old / nloc;
        if (old + 1u == (gen + 1u) * nloc) {
            __builtin_amdgcn_fence(__ATOMIC_RELEASE, "agent");
            asm volatile("s_waitcnt vmcnt(0)" ::: "memory");
            const unsigned og = xb_add(&bar[XB_TOP], 1u);
            const unsigned tg = og / nx;
            if (og + 1u == (tg + 1u) * nx) xb_add(&bar[XB_TOPGEN], 1u);
            else XB_SPIN(xb_ld(&bar[XB_TOPGEN]) == tg, bar);
            __builtin_amdgcn_fence(__ATOMIC_ACQUIRE, "agent");
            xb_add(&bar[XB_XGEN(b.x)], 1u);
            asm volatile("s_waitcnt vmcnt(0)" ::: "memory");
        } else {
            XB_SPIN(xb_ld(&bar[XB_XGEN(b.x)]) == gen, bar);
            __builtin_amdgcn_fence(__ATOMIC_ACQUIRE, "agent");
            asm volatile("s_waitcnt vmcnt(0)" ::: "memory");
        }
    }
    __syncthreads();
}
constexpr int NWAVES = 8;
#ifndef MK_N_LAUNCHES
#define MK_N_LAUNCHES 1
#endif
constexpr int N_PHASES = 7;
constexpr int N_LAUNCHES = MK_N_LAUNCHES;

constexpr int BATCH = 16, SEQ = 2048, D = 1024, M = BATCH * SEQ;
constexpr int CHUNK = 64, NCHUNK = SEQ / CHUNK;
constexpr int D_IN = 3384, NPROJ = 3584;
constexpr int FF = 2816, NGU = 2 * FF;
constexpr float EPS = 1e-6f;
constexpr int NP2 = 2048;
constexpr int C_QI = 0, C_QB = 256, C_KB = 512, C_VB = 768, C_OG = 1280, C_KI = 1792, C_WI = 1824, C_GD = 1832;
__host__ __device__ __forceinline__ int in_src(int r) {
    if (r < 1024) return r;
    if (r < 1280) return 1536 + (r - 1024);
    if (r < 1536) return 1832 + (r - 1280);
    if (r < 1792) return 2088 + (r - 1536);
    if (r < 2304) return 2344 + (r - 1792);
    if (r < 2816) return 2872 + (r - 2304);
    if (r < 2848) return 1792 + (r - 2816);
    if (r < 2856) return 1824 + (r - 2848);
    if (r < 2872) return 2856 + (r - 2856);
    if (r < 3072) return -1;
    return 1024 + (r - 3072);
}
__host__ __device__ __forceinline__ size_t qk_idx(int b, int h, int t, int d) { return (size_t)((b * 8 + h) * 64 + (t >> 5)) * 2048 + (d >> 4) * 512 + (((d >> 3) & 1) * 32 + (t & 31)) * 8 + (d & 7); }
__host__ __device__ __forceinline__ size_t vt_idx(int b, int h, int t, int d) { return (size_t)((b * 8 + h) * 64 + (t >> 5)) * 2048 + (d >> 5) * 1024 + ((t >> 4) & 1) * 512 + (((t >> 2) & 1) * 32 + (d & 31)) * 8 + 4 * ((t >> 3) & 1) + (t & 3); }

constexpr size_t MiB = 1u << 20;
constexpr size_t WS_CTL = 0, CTL_ZERO_BYTES = 1 * MiB;
constexpr size_t WS_WIN = 2 * MiB;
constexpr size_t WS_WOUT = 9 * MiB;
constexpr size_t WS_WGU = 11 * MiB;
constexpr size_t WS_WDN = 22 * MiB;
constexpr size_t WS_RS1 = 28 * MiB;
constexpr size_t WS_RS2 = 30 * MiB;
constexpr size_t WS_H = 40 * MiB;
constexpr size_t WS_QT = 104 * MiB, WS_KT = 136 * MiB, WS_VT = 168 * MiB;
constexpr size_t WS_P2 = 200 * MiB;
constexpr size_t WS_ACT = 104 * MiB;
constexpr size_t WS_MIX = 328 * MiB;
constexpr size_t WS_END = 392 * MiB;
constexpr int CW_BAR = 4096;
constexpr int CW_QUEUE = 64;

constexpr int RING_OFF = 0, RING_BYTES = 131072;
constexpr int BM_OFF = RING_BYTES;
constexpr int TB_OFF = BM_OFF + 64 * 33 * 8;
constexpr int LDSCTL_OFF = TB_OFF + 8192, MISC_OFF = LDSCTL_OFF + 320;
constexpr int LDS_BYTES = LDSCTL_OFF + 1536;
static_assert(LDS_BYTES <= 160 * 1024, "LDS map");

#define GAS __attribute__((address_space(1)))
#ifndef LAS
#define LAS __attribute__((address_space(3)))
#endif
typedef unsigned short bf16;
typedef unsigned v4u __attribute__((ext_vector_type(4)));
typedef unsigned v2u __attribute__((ext_vector_type(2)));
typedef float f32x4 __attribute__((ext_vector_type(4)));
#define LDS_WAIT() asm volatile("s_waitcnt lgkmcnt(0)" ::: "memory")
#define VM_WAIT() asm volatile("s_waitcnt vmcnt(0)" ::: "memory")
__device__ __forceinline__ unsigned f2bf(float f) { unsigned u = __builtin_bit_cast(unsigned, f); return (u + 0x7fffu + ((u >> 16) & 1u)) >> 16; }
__device__ __forceinline__ unsigned pk2(float lo, float hi) { return f2bf(lo) | (f2bf(hi) << 16); }
__device__ __forceinline__ float bf2f(unsigned short b) { return __builtin_bit_cast(float, (unsigned)b << 16); }
__device__ __forceinline__ float bflo(unsigned w) { return __builtin_bit_cast(float, w << 16); }
__device__ __forceinline__ float bfhi(unsigned w) { return __builtin_bit_cast(float, w & 0xffff0000u); }

struct Frame {
    LAS unsigned char* lds;
    volatile LAS unsigned* MISC;
    unsigned* ctl;
    int tid, lane, wave, G;
    const float *x, *norm_mix, *w_in, *w_gate_up, *b_gate, *gla_norm, *w_out, *rel_bias, *norm_ffn, *w_ffn_gate, *w_ffn_up, *w_ffn_down, *norm_final;
    float* out;
    bf16 *WIN, *WOUT, *WGU, *WDN, *H, *QT, *KT, *VT, *P2, *MIX, *ACT;
    float *RS1, *RS2;
};

__device__ __forceinline__ float wave_sum(float v) {
#pragma unroll
    for (int o = 1; o < 64; o <<= 1) v += __shfl_xor(v, o);
    return v;
}
__device__ __forceinline__ float wave_max(float v) {
#pragma unroll
    for (int o = 1; o < 64; o <<= 1) v = fmaxf(v, __shfl_xor(v, o));
    return v;
}
__device__ __forceinline__ int wave_sum_i(int v) {
#pragma unroll
    for (int o = 1; o < 64; o <<= 1) v += __shfl_xor(v, o);
    return v;
}

__device__ __forceinline__ void p0_item(const float* cp, int ld, bf16* WT, int K, int r0, int k0, LAS float* scr, int lane) {
    float tv[32];
#pragma unroll
    for (int i = 0; i < 32; ++i) { const int kk = 2 * i + (lane >> 5); tv[i] = cp ? cp[(size_t)(k0 + kk) * ld] : 0.f; }
#pragma unroll
    for (int i = 0; i < 32; ++i) { const int kk = 2 * i + (lane >> 5); scr[kk * 33 + (lane & 31)] = tv[i]; }
    LDS_WAIT(); asm volatile("" ::: "memory");
    const int c = lane & 7;
#pragma unroll
    for (int j = 0; j < 4; ++j) { const int n = (lane >> 3) + 8 * j; const LAS float* s = scr + (8 * c) * 33 + n;
        v4u o; o.x = pk2(s[0 * 33], s[1 * 33]); o.y = pk2(s[2 * 33], s[3 * 33]); o.z = pk2(s[4 * 33], s[5 * 33]); o.w = pk2(s[6 * 33], s[7 * 33]);
        *(v4u*)(WT + (size_t)(r0 + n) * K + k0 + 8 * c) = o; }
    LDS_WAIT(); asm volatile("" ::: "memory");
}
__device__ __forceinline__ void p0_prologue(Frame& F) {
    LAS float* scr = (LAS float*)(F.lds + RING_OFF + F.wave * 16384);
    const int gw = blockIdx.x * NWAVES + F.wave, NGW = F.G * NWAVES, lane = F.lane;
    constexpr int I_IN = (D / 64) * (NPROJ / 32), I_OUT = (D / 64) * (D / 32), I_GU = (D / 64) * (NGU / 32), I_DN = (FF / 64) * (D / 32);
    constexpr int NITEMS = I_IN + I_OUT + I_GU + I_DN;
    for (int it = gw; it < NITEMS; it += NGW) {
        int r = it;
        if (r < I_IN) { const int kb = r / (NPROJ / 32), nb = r % (NPROJ / 32); const int sc = in_src(32 * nb + (lane & 31));
            p0_item(sc >= 0 ? F.w_in + sc : nullptr, D_IN, F.WIN, D, 32 * nb, 64 * kb, scr, lane); continue; }
        r -= I_IN;
        if (r < I_OUT) { const int kb = r / (D / 32), nb = r % (D / 32);
            p0_item(F.w_out + 32 * nb + (lane & 31), D, F.WOUT, D, 32 * nb, 64 * kb, scr, lane); continue; }
        r -= I_OUT;
        if (r < I_GU) { const int kb = r / (NGU / 32), nb = r % (NGU / 32); const int rr = 32 * nb + (lane & 31), t = rr >> 8, j = rr & 255;
            const float* cp = (j < 128) ? F.w_ffn_gate + 128 * t + j : F.w_ffn_up + 128 * t + (j - 128);
            p0_item(cp, FF, F.WGU, D, 32 * nb, 64 * kb, scr, lane); continue; }
        r -= I_GU;
        { const int kb = r / (D / 32), nb = r % (D / 32);
            p0_item(F.w_ffn_down + 32 * nb + (lane & 31), D, F.WDN, FF, 32 * nb, 64 * kb, scr, lane); }
    }
    f32x4 gv[4];
#pragma unroll
    for (int j = 0; j < 4; ++j) gv[j] = ((const f32x4*)F.norm_mix)[lane + 64 * j];
    for (int m0 = 4 * gw; m0 < M; m0 += 4 * NGW) {
        f32x4 v[4][4];
#pragma unroll
        for (int r = 0; r < 4; ++r)
#pragma unroll
            for (int j = 0; j < 4; ++j) v[r][j] = ((const f32x4*)(F.x + (size_t)(m0 + r) * D))[lane + 64 * j];
#pragma unroll
        for (int r = 0; r < 4; ++r) { float s = 0.f;
#pragma unroll
            for (int j = 0; j < 4; ++j) s += (v[r][j].x * v[r][j].x + v[r][j].y * v[r][j].y) + (v[r][j].z * v[r][j].z + v[r][j].w * v[r][j].w);
            const float rr = 1.0f / sqrtf(wave_sum(s) * (1.0f / D) + EPS);
            v2u* o8 = (v2u*)(F.H + (size_t)(m0 + r) * D) + lane;
#pragma unroll
            for (int j = 0; j < 4; ++j) { v2u w; w.x = pk2(v[r][j].x * rr * gv[j].x, v[r][j].y * rr * gv[j].y); w.y = pk2(v[r][j].z * rr * gv[j].z, v[r][j].w * rr * gv[j].w); o8[64 * j] = w; } }
    }
}

__device__ __forceinline__ int t5_bucket(int rel) {
    const int ret = rel > 0 ? 16 : 0; const int n = rel < 0 ? -rel : rel;
    const int v = n < 8 ? n : n < 12 ? 8 : n < 16 ? 9 : n < 23 ? 10 : n < 32 ? 11 : n < 46 ? 12 : n < 64 ? 13 : n < 91 ? 14 : 15;
    return ret + v;
}
__device__ __forceinline__ unsigned ord_key(float s) { const unsigned b = __builtin_bit_cast(unsigned, s + 0.0f); return (b & 0x80000000u) ? ~b : (b | 0x80000000u); }

__device__ __forceinline__ void dsa_simple(Frame& F) {
    LAS unsigned char* wl = F.lds + RING_OFF + F.wave * 16384;
    LAS float* sc = (LAS float*)wl;
    LAS float* qs = (LAS float*)(wl + 8192);
    LAS float* wq = (LAS float*)(wl + 9216);
    LAS unsigned* list = (LAS unsigned*)(wl + 9472);
    LAS float* pl = (LAS float*)(wl + 10496);
    LAS float* qh = (LAS float*)(wl + 11520);
    const int lane = F.lane, gw = blockIdx.x * NWAVES + F.wave, NGW = F.G * NWAVES;
    const unsigned long long lt = (1ull << lane) - 1ull;
    for (int w = gw; w < M; w += NGW) {
        const int b = w / SEQ, t = ((w % SEQ) + 131 * b) % SEQ, n = t >> 6, L = (n + 1) * CHUNK, nj = n + 1;
        const size_t m = (size_t)b * SEQ + t;
        const bf16* prow = F.P2 + m * NP2;
        { const v2u qv = *(const v2u*)(prow + C_QI + 4 * lane); qs[4 * lane] = bflo(qv.x); qs[4 * lane + 1] = bfhi(qv.x); qs[4 * lane + 2] = bflo(qv.y); qs[4 * lane + 3] = bfhi(qv.y);
          if (lane < 8) wq[lane] = bf2f(prow[C_WI + lane]) * 0.0625f; }
        LDS_WAIT(); asm volatile("" ::: "memory");
        for (int j = 0; j < nj; ++j) {
            const int key = j * 64 + lane; const v4u* kp = (const v4u*)(F.P2 + ((size_t)b * SEQ + key) * NP2 + C_KI);
            float ki[32];
#pragma unroll
            for (int q = 0; q < 4; ++q) { const v4u kv = kp[q]; ki[8 * q] = bflo(kv.x); ki[8 * q + 1] = bfhi(kv.x); ki[8 * q + 2] = bflo(kv.y); ki[8 * q + 3] = bfhi(kv.y);
                ki[8 * q + 4] = bflo(kv.z); ki[8 * q + 5] = bfhi(kv.z); ki[8 * q + 6] = bflo(kv.w); ki[8 * q + 7] = bfhi(kv.w); }
            float s = 0.f;
#pragma unroll 1
            for (int h = 0; h < 8; ++h) { float d = 0.f;
#pragma unroll
                for (int dd = 0; dd < 32; ++dd) d += qs[h * 32 + dd] * ki[dd];
                s += wq[h] * fmaxf(d, 0.f); }
            sc[key] = s;
        }
        LDS_WAIT(); asm volatile("" ::: "memory");
        unsigned selbits = 0u;
        if (L <= 256) selbits = (1u << nj) - 1u;
        else {
            unsigned u[32];
#pragma unroll
            for (int j = 0; j < 32; ++j) u[j] = (j < nj) ? ord_key(sc[j * 64 + lane]) : 0u;
            unsigned T = 0u;
            for (int bit = 31; bit >= 0; --bit) { const unsigned cand = T | (1u << bit); int c = 0;
#pragma unroll
                for (int j = 0; j < 32; ++j) c += (u[j] >= cand) ? 1 : 0;
                c = wave_sum_i(c); if (c >= 256) T = cand; }
            int cg = 0;
#pragma unroll
            for (int j = 0; j < 32; ++j) cg += (u[j] > T) ? 1 : 0;
            cg = wave_sum_i(cg); const int r = 256 - cg; int run = 0;
#pragma unroll
            for (int j = 0; j < 32; ++j) { const bool eq = (u[j] == T); const unsigned long long em = __ballot(eq); const int pre = run + __popcll(em & lt);
                if ((u[j] > T) || (eq && pre < r)) selbits |= (1u << j); run += __popcll(em); }
        }
        int nsel = 0;
#pragma unroll
        for (int j = 0; j < 32; ++j) { const bool s = (selbits >> j) & 1u; const unsigned long long mk = __ballot(s); if (s) list[nsel + __popcll(mk & lt)] = (unsigned)(j * 64 + lane); nsel += __popcll(mk); }
        LDS_WAIT(); asm volatile("" ::: "memory");
        for (int h = 0; h < 8; ++h) {
            qh[lane] = bf2f(F.QT[qk_idx(b, h, t, lane)]);
            LDS_WAIT(); asm volatile("" ::: "memory");
            float lg[4]; float mx = -1e30f;
#pragma unroll
            for (int c = 0; c < 4; ++c) { const int idx = c * 64 + lane; lg[c] = -1e30f;
                if (idx < nsel) { const int key = (int)list[idx]; float d = 0.f;
#pragma unroll
                    for (int q = 0; q < 8; ++q) { const v4u kv = *(const v4u*)(F.KT + qk_idx(b, h, key, 8 * q)); d += qh[8 * q] * bflo(kv.x) + qh[8 * q + 1] * bfhi(kv.x) + qh[8 * q + 2] * bflo(kv.y) + qh[8 * q + 3] * bfhi(kv.y)
                        + qh[8 * q + 4] * bflo(kv.z) + qh[8 * q + 5] * bfhi(kv.z) + qh[8 * q + 6] * bflo(kv.w) + qh[8 * q + 7] * bfhi(kv.w); }
                    lg[c] = d + F.rel_bias[t5_bucket(key - t) * 8 + h]; }
                mx = fmaxf(mx, lg[c]); }
            mx = wave_max(mx); float sum = 0.f;
#pragma unroll
            for (int c = 0; c < 4; ++c) { const int idx = c * 64 + lane; lg[c] = (idx < nsel) ? __expf(lg[c] - mx) : 0.f; sum += lg[c]; }
            sum = wave_sum(sum); const float inv = 1.0f / sum;
#pragma unroll
            for (int c = 0; c < 4; ++c) pl[c * 64 + lane] = lg[c] * inv;
            LDS_WAIT(); asm volatile("" ::: "memory");
            float o = 0.f;
            for (int i = 0; i < nsel; ++i) { const int key = (int)list[i]; o += pl[i] * bf2f(F.VT[vt_idx(b, h, key, lane)]); }
            F.MIX[m * D + h * 64 + lane] = (bf16)f2bf(o);
            LDS_WAIT(); asm volatile("" ::: "memory");
        }
    }
}


typedef short bf16x8 __attribute__((ext_vector_type(8)));
typedef float f32x16 __attribute__((ext_vector_type(16)));
__device__ __forceinline__ bf16x8 pack8(float a0, float a1, float a2, float a3, float a4, float a5, float a6, float a7) {
    typedef __bf16 b2 __attribute__((ext_vector_type(2))); typedef float f2 __attribute__((ext_vector_type(2)));
    v4u r;
    r.x = __builtin_bit_cast(unsigned, __builtin_convertvector((f2){a0, a1}, b2)); r.y = __builtin_bit_cast(unsigned, __builtin_convertvector((f2){a2, a3}, b2));
    r.z = __builtin_bit_cast(unsigned, __builtin_convertvector((f2){a4, a5}, b2)); r.w = __builtin_bit_cast(unsigned, __builtin_convertvector((f2){a6, a7}, b2));
    return __builtin_bit_cast(bf16x8, r);
}
__device__ __forceinline__ void dsa_bias_table(Frame& F) {
    LAS float* tb = (LAS float*)(F.lds + TB_OFF);
    for (int e = F.tid; e < 2048; e += NWAVES * 64) { const int h = e >> 8, i = e & 255; tb[e] = (i < 255) ? (F.rel_bias[t5_bucket(i - 191) * 8 + h] - F.rel_bias[15 * 8 + h]) * 1.44269504f : 0.f; }
}
__device__ __forceinline__ unsigned long long cmp_ge_mask(unsigned u, unsigned t) { unsigned long long m; asm("v_cmp_ge_u32_e64 %0, %1, %2" : "=s"(m) : "v"(u), "s"(t)); return m; }
__device__ __forceinline__ unsigned long long cmp_gt_mask(unsigned u, unsigned t) { unsigned long long m; asm("v_cmp_gt_u32_e64 %0, %1, %2" : "=s"(m) : "v"(u), "s"(t)); return m; }
__device__ __forceinline__ unsigned long long cmp_eq_mask(unsigned u, unsigned t) { unsigned long long m; asm("v_cmp_eq_u32_e64 %0, %1, %2" : "=s"(m) : "v"(u), "s"(t)); return m; }
__device__ __forceinline__ int count4_ge(unsigned u0, unsigned u1, unsigned u2, unsigned u3, unsigned t) {
    unsigned long long m0, m1, m2, m3;
    asm("v_cmp_ge_u32_e64 %0, %4, %8\n\tv_cmp_ge_u32_e64 %1, %5, %8\n\tv_cmp_ge_u32_e64 %2, %6, %8\n\tv_cmp_ge_u32_e64 %3, %7, %8" : "=&s"(m0), "=&s"(m1), "=&s"(m2), "=&s"(m3) : "v"(u0), "v"(u1), "v"(u2), "v"(u3), "s"(t));
    return (__popcll(m0) + __popcll(m1)) + (__popcll(m2) + __popcll(m3));
}
__device__ __forceinline__ unsigned ord_key_raw(float f) { const unsigned b = __builtin_bit_cast(unsigned, f); return (b & 0x80000000u) ? ~b : (b | 0x80000000u); }
__device__ __forceinline__ float ord_key_inv(unsigned u) { return __builtin_bit_cast(float, (u & 0x80000000u) ? (u ^ 0x80000000u) : ~u); }
#define DPP_STEP(op, ident, ctrl, rmask) v = op(v, __builtin_amdgcn_update_dpp(ident, v, ctrl, rmask, 0xf, false))
#define DPP_SCAN(op, ident) DPP_STEP(op, ident, 0x111, 0xf); DPP_STEP(op, ident, 0x112, 0xf); DPP_STEP(op, ident, 0x114, 0xf); DPP_STEP(op, ident, 0x118, 0xf); DPP_STEP(op, ident, 0x142, 0xa); DPP_STEP(op, ident, 0x143, 0xc)
__device__ __forceinline__ int dpp_addi(int a, int b) { return a + b; }
__device__ __forceinline__ int dpp_maxu(int a, int b) { return (int)(((unsigned)a > (unsigned)b) ? (unsigned)a : (unsigned)b); }
__device__ __forceinline__ int dpp_minu(int a, int b) { return (int)(((unsigned)a < (unsigned)b) ? (unsigned)a : (unsigned)b); }
__device__ __forceinline__ int wave_total_i(int v) { DPP_SCAN(dpp_addi, 0); return __builtin_amdgcn_readlane(v, 63); }
__device__ __forceinline__ unsigned wave_max_u(unsigned x) { int v = (int)x; DPP_SCAN(dpp_maxu, 0); return (unsigned)__builtin_amdgcn_readlane(v, 63); }
__device__ __forceinline__ unsigned wave_min_u(unsigned x) { int v = (int)x; DPP_SCAN(dpp_minu, -1); return (unsigned)__builtin_amdgcn_readlane(v, 63); }
#define DSA_FOR_J(...) do { _Pragma("unroll") for (int j = 0; j < 8; ++j) { __VA_ARGS__ } \
    if (nk > 8) { _Pragma("unroll") for (int j = 8; j < 16; ++j) { __VA_ARGS__ } } \
    if (nk > 16) { _Pragma("unroll") for (int j = 16; j < 24; ++j) { __VA_ARGS__ } } \
    if (nk > 24) { _Pragma("unroll") for (int j = 24; j < 32; ++j) { __VA_ARGS__ } } } while (0)
template <int MODE = 0> __device__ __forceinline__ void dsa_select(Frame& F, int b, int n) {
    const int lane = F.lane, wave = F.wave, tid = F.tid, L = (n + 1) * CHUNK, nk = n + 1;
    LAS float* sc = (LAS float*)(F.lds + RING_OFF);
    LAS unsigned long long* bm = (LAS unsigned long long*)(F.lds + BM_OFF);
    const size_t tokb = (size_t)b * SEQ;
    if (nk <= 4) { for (int e = tid; e < 64 * nk; e += NWAVES * 64) bm[(e / nk) * 33 + (e % nk)] = ~0ull; return; }
    const int fr = lane & 15, fq = lane >> 4;
    const int ntl = (4 * nk - wave + 7) >> 3;
    for (int sb = 0; sb < 4; ++sb) {
        const int q0 = 64 * n + 16 * sb;
        {
            bf16x8 qf[8];
#pragma unroll
            for (int h = 0; h < 8; ++h) qf[h] = *(const bf16x8*)(F.P2 + (tokb + q0 + fr) * NP2 + C_QI + h * 32 + 8 * fq);
            float wv[4][8];
#pragma unroll
            for (int r = 0; r < 4; ++r) { const v4u w = *(const v4u*)(F.P2 + (tokb + q0 + 4 * fq + r) * NP2 + C_WI);
                wv[r][0] = bflo(w.x) * 0.0625f; wv[r][1] = bfhi(w.x) * 0.0625f; wv[r][2] = bflo(w.y) * 0.0625f; wv[r][3] = bfhi(w.y) * 0.0625f;
                wv[r][4] = bflo(w.z) * 0.0625f; wv[r][5] = bfhi(w.z) * 0.0625f; wv[r][6] = bflo(w.w) * 0.0625f; wv[r][7] = bfhi(w.w) * 0.0625f; }
#define DSA_LDK(i_) (*(const bf16x8*)(F.P2 + (tokb + 16 * (wave + 8 * (((i_) < ntl) ? (i_) : (ntl - 1))) + fr) * NP2 + C_KI + 8 * fq))
#define DSA_TILE(kfv, i_) do { if ((i_) < ntl) { f32x4 s = {0.f, 0.f, 0.f, 0.f}; \
                _Pragma("unroll") for (int h = 0; h < 8; ++h) { const f32x4 d = __builtin_amdgcn_mfma_f32_16x16x32_bf16(qf[h], kfv, (f32x4){0.f, 0.f, 0.f, 0.f}, 0, 0, 0); \
                    _Pragma("unroll") for (int r = 0; r < 4; ++r) s[r] += wv[r][h] * fmaxf(d[r], 0.f); } \
                _Pragma("unroll") for (int r = 0; r < 4; ++r) scw[r * L + 128 * (i_)] = s[r] + 0.0f; } } while (0)
            LAS float* scw = sc + 4 * fq * L + ((16 * wave + fr) ^ ((fq & 1) << 4));
            bf16x8 k0 = DSA_LDK(0), k1 = DSA_LDK(1), k2 = DSA_LDK(2), k3 = DSA_LDK(3);
            for (int i = 0; i < ntl; i += 4) {
                DSA_TILE(k0, i);     k0 = DSA_LDK(i + 4);
                DSA_TILE(k1, i + 1); k1 = DSA_LDK(i + 5);
                DSA_TILE(k2, i + 2); k2 = DSA_LDK(i + 6);
                DSA_TILE(k3, i + 3); k3 = DSA_LDK(i + 7);
            }
#undef DSA_LDK
#undef DSA_TILE
        }
        __syncthreads();
        if (MODE == 1) continue;
        {
            const int qa = 2 * wave, qb = 2 * wave + 1;
            unsigned ua[32], ub[32];
#pragma unroll
            for (int j = 0; j < 32; ++j) { ua[j] = 0u; ub[j] = 0u; }
            const LAS float* sca = sc + qa * L + (lane ^ (((qa >> 2) & 1) << 4)); const LAS float* scb = sc + qb * L + (lane ^ (((qb >> 2) & 1) << 4));
            DSA_FOR_J( if (j < nk) { ua[j] = ord_key(sca[j * 64]); ub[j] = ord_key(scb[j * 64]); } );
            unsigned xa = 0u, na_ = 0xffffffffu, xb = 0u, nb_ = 0xffffffffu;
            DSA_FOR_J( if (j < nk) { xa = ua[j] > xa ? ua[j] : xa; na_ = ua[j] < na_ ? ua[j] : na_; xb = ub[j] > xb ? ub[j] : xb; nb_ = ub[j] < nb_ ? ub[j] : nb_; } );
            unsigned loa = wave_min_u(na_), hia = wave_max_u(xa) + 1u, Ta = loa, lob = wave_min_u(nb_), hib = wave_max_u(xb) + 1u, Tb = lob;
            bool da = (MODE == 2), db = (MODE == 2);
            int iters = 0;
            unsigned ma = 0x80000000u, mb = 0x80000000u;
            unsigned cza = 0u, czb = 0u;
            while (!(da && db)) {
                if (MODE >= 10 && iters > MODE - 10) break;
                if (iters >= 2) {
                    const bool keyspace = iters > 24;
                    ma = Ta; mb = Tb;
                    if (!da) { if (hia - loa <= 1u) { Ta = loa; da = true; ma = loa; } else { ma = ord_key_raw(0.5f * (ord_key_inv(loa) + ord_key_inv(hia))); if (keyspace || ma <= loa || ma >= hia) ma = loa + ((hia - loa) >> 1); } }
                    if (!db) { if (hib - lob <= 1u) { Tb = lob; db = true; mb = lob; } else { mb = ord_key_raw(0.5f * (ord_key_inv(lob) + ord_key_inv(hib))); if (keyspace || mb <= lob || mb >= hib) mb = lob + ((hib - lob) >> 1); } }
                } else if (iters == 1) { ma = 0x80000001u; mb = 0x80000001u; }
                ++iters;
                const unsigned sma = __builtin_amdgcn_readfirstlane(ma), smb = __builtin_amdgcn_readfirstlane(mb);
                int ca = 0, cb = 0;
#define DSA_CNT8(j0) do { const int a0 = count4_ge(ua[j0], ua[j0 + 1], ua[j0 + 2], ua[j0 + 3], sma), b0 = count4_ge(ub[j0], ub[j0 + 1], ub[j0 + 2], ub[j0 + 3], smb); \
                    const int a1 = count4_ge(ua[j0 + 4], ua[j0 + 5], ua[j0 + 6], ua[j0 + 7], sma), b1 = count4_ge(ub[j0 + 4], ub[j0 + 5], ub[j0 + 6], ub[j0 + 7], smb); ca += a0 + a1; cb += b0 + b1; } while (0)
                DSA_CNT8(0); if (nk > 8) DSA_CNT8(8); if (nk > 16) DSA_CNT8(16); if (nk > 24) DSA_CNT8(24);
#undef DSA_CNT8
                if (!da) { if (ca >= 256) { if (ma > loa) loa = ma; } else { if (ma < hia) hia = ma; } if (ca == 256) { Ta = ma; da = true; } }
                if (!db) { if (cb >= 256) { if (mb > lob) lob = mb; } else { if (mb < hib) hib = mb; } if (cb == 256) { Tb = mb; db = true; } }
            }
#pragma unroll
            for (int which = 0; which < 2; ++which) {
                const unsigned T = __builtin_amdgcn_readfirstlane(which ? Tb : Ta);
                int cg = 0;
                DSA_FOR_J( cg += __popcll(cmp_gt_mask(which ? ub[j] : ua[j], T)); );
                int r = 256 - cg;
                LAS unsigned long long* bmq = bm + (16 * sb + (which ? qb : qa)) * 33;
                DSA_FOR_J( { const unsigned uu = which ? ub[j] : ua[j]; const unsigned long long mgt = cmp_gt_mask(uu, T); unsigned long long meq = cmp_eq_mask(uu, T); int ne = __popcll(meq);
                    if (ne > r) { unsigned long long keep = 0ull, t2 = meq; for (int c = 0; c < r; ++c) { const unsigned long long low = t2 & (~t2 + 1ull); keep |= low; t2 ^= low; } meq = keep; ne = r; }
                    r -= ne;
                    if (lane == 0) bmq[j] = mgt | meq; } );
            }
        }
        __syncthreads();
    }
}
__device__ __forceinline__ void dsa_attend(Frame& F, int b, int n, bf16* MIXO) {
    const int lane = F.lane, h = F.wave, nk = n + 1, qq = lane & 31, hh = lane >> 5;
    const LAS unsigned* bm32 = (const LAS unsigned*)(F.lds + BM_OFF);
    const LAS float* tbw = (const LAS float*)(F.lds + TB_OFF) + h * 256;
    const size_t hb = (size_t)((b * 8 + h) * 64) * 2048;
    const bf16* Qb = F.QT + hb; const bf16* Kb = F.KT + hb; const bf16* Vb = F.VT + hb;
    constexpr float LOG2E = 1.44269504f;
    bf16x8 qf[2][4];
#pragma unroll
    for (int qt = 0; qt < 2; ++qt)
#pragma unroll
        for (int ks = 0; ks < 4; ++ks) qf[qt][ks] = *(const bf16x8*)(Qb + (size_t)(2 * n + qt) * 2048 + ks * 512 + lane * 8);
    f32x16 o[2][2];
#pragma unroll
    for (int dt = 0; dt < 2; ++dt)
#pragma unroll
        for (int qt = 0; qt < 2; ++qt)
#pragma unroll
            for (int i = 0; i < 16; ++i) o[dt][qt][i] = 0.f;
    float mrow[2] = {-1e30f, -1e30f}, lsum[2] = {0.f, 0.f};
    bf16x8 kfr[4], vfr[2][2];
#pragma unroll
    for (int ks = 0; ks < 4; ++ks) kfr[ks] = *(const bf16x8*)(Kb + ks * 512 + lane * 8);
#pragma unroll
    for (int dt = 0; dt < 2; ++dt)
#pragma unroll
        for (int s = 0; s < 2; ++s) vfr[dt][s] = *(const bf16x8*)(Vb + dt * 1024 + s * 512 + lane * 8);
    for (int j2 = 0; j2 < 2 * nk; ++j2) {
        bf16x8 kn[4], vn[2][2];
        const size_t jn = (size_t)((j2 + 1 < 2 * nk) ? j2 + 1 : j2) * 2048;
#pragma unroll
        for (int ks = 0; ks < 4; ++ks) kn[ks] = *(const bf16x8*)(Kb + jn + ks * 512 + lane * 8);
#pragma unroll
        for (int dt = 0; dt < 2; ++dt)
#pragma unroll
            for (int s = 0; s < 2; ++s) vn[dt][s] = *(const bf16x8*)(Vb + jn + dt * 1024 + s * 512 + lane * 8);
        const bool near = ((j2 >> 1) >= n - 2);
#pragma unroll
        for (int qt = 0; qt < 2; ++qt) {
            f32x16 st;
#pragma unroll
            for (int i = 0; i < 16; ++i) st[i] = 0.f;
#pragma unroll
            for (int ks = 0; ks < 4; ++ks) st = __builtin_amdgcn_mfma_f32_32x32x16_bf16(kfr[ks], qf[qt][ks], st, 0, 0, 0);
            const unsigned ww = bm32[(32 * qt + qq) * 66 + j2] >> (4 * hh);
            if (near) {
                const LAS float* tbp = tbw + (32 * j2 - 64 * n - 32 * qt + 4 * hh - qq + 191);
#pragma unroll
                for (int i = 0; i < 16; ++i) st[i] += tbp[(i & 3) + 8 * (i >> 2)];
            }
            float mx = fmaxf(fmaxf(st[0], st[1]), st[2]);
#pragma unroll
            for (int i = 3; i < 15; i += 2) mx = fmaxf(fmaxf(mx, st[i]), st[i + 1]);
            mx = fmaxf(mx, st[15]);
            mx = fmaxf(mx, __shfl_xor(mx, 32));
            if (__any(mx > mrow[qt])) {
                const float mnew = fmaxf(mrow[qt], mx), alpha = __builtin_amdgcn_exp2f(mrow[qt] - mnew);
                mrow[qt] = mnew; lsum[qt] *= alpha;
#pragma unroll
                for (int dt = 0; dt < 2; ++dt)
#pragma unroll
                    for (int i = 0; i < 16; ++i) o[dt][qt][i] *= alpha;
            }
            const float mb = mrow[qt];
            float ps = 0.f;
#pragma unroll
            for (int i = 0; i < 16; ++i) { const int bit = (i & 3) + 8 * (i >> 2);
                const unsigned pb = __builtin_bit_cast(unsigned, __builtin_amdgcn_exp2f(st[i] - mb)) & (unsigned)__builtin_amdgcn_sbfe((int)ww, bit, 1);
                const float p = __builtin_bit_cast(float, pb); st[i] = p; ps += p; }
            lsum[qt] += ps;
#pragma unroll
            for (int s = 0; s < 2; ++s) {
                const bf16x8 pf = pack8(st[8 * s], st[8 * s + 1], st[8 * s + 2], st[8 * s + 3], st[8 * s + 4], st[8 * s + 5], st[8 * s + 6], st[8 * s + 7]);
#pragma unroll
                for (int dt = 0; dt < 2; ++dt) o[dt][qt] = __builtin_amdgcn_mfma_f32_32x32x16_bf16(vfr[dt][s], pf, o[dt][qt], 0, 0, 0);
            }
        }
#pragma unroll
        for (int ks = 0; ks < 4; ++ks) kfr[ks] = kn[ks];
#pragma unroll
        for (int dt = 0; dt < 2; ++dt)
#pragma unroll
            for (int s = 0; s < 2; ++s) vfr[dt][s] = vn[dt][s];
    }
#pragma unroll
    for (int qt = 0; qt < 2; ++qt) {
        const float l = lsum[qt] + __shfl_xor(lsum[qt], 32), inv = 1.0f / l;
        bf16* orow = MIXO + ((size_t)b * SEQ + 64 * n + 32 * qt + qq) * D + h * 64;
#pragma unroll
        for (int dt = 0; dt < 2; ++dt)
#pragma unroll
            for (int g = 0; g < 4; ++g) { v2u w; w.x = pk2(o[dt][qt][4 * g] * inv, o[dt][qt][4 * g + 1] * inv); w.y = pk2(o[dt][qt][4 * g + 2] * inv, o[dt][qt][4 * g + 3] * inv);
                *(v2u*)(orow + 32 * dt + 8 * g + 4 * hh) = w; }
    }
}
template <bool SELECT_ONLY = false, int MODE = 0> __device__ __forceinline__ void dsa_fast(Frame& F, int qword) {
    dsa_bias_table(F);
    __syncthreads();
    for (;;) {
        if (F.tid == 0) F.MISC[16] = atomicAdd(F.ctl + qword + 64 * (blockIdx.x & 7), 1u);
        __syncthreads();
        const unsigned id = F.MISC[16];
        if (id >= 64u) break;
        const int n = NCHUNK - 1 - (int)(id & 31), b = 2 * (int)(blockIdx.x & 7) + (int)(id >> 5);
        if (MODE != 99) dsa_select<MODE>(F, b, n);
        __syncthreads();
        if (!SELECT_ONLY) dsa_attend(F, b, n, MODE == 99 ? (bf16*)((unsigned char*)F.ctl + WS_END) : F.MIX);
        __syncthreads();
    }
}


constexpr int GS = 72;
constexpr int G_QIN = 0, G_KIN = G_QIN + 64 * GS * 2, G_KINT = G_KIN + 64 * GS * 2, G_VT = G_KINT + 64 * GS * 2, G_ST = G_VT + 128 * GS * 2;
constexpr int G_WG = G_ST + 2 * 128 * GS * 2, G_BG = G_WG + 16 * 64 * 4, G_EBL = G_BG + 256, G_PP = G_EBL + 256, G_END = G_PP + 2 * 4 * 64 * 4;
static_assert(G_END <= RING_BYTES, "GLA LDS map");
typedef short bf16x4 __attribute__((ext_vector_type(4)));
__device__ __forceinline__ float wave_incl_scan(float v) {
#define DPP_ADD(ctrl, rmask) v += __builtin_bit_cast(float, __builtin_amdgcn_update_dpp(0, __builtin_bit_cast(int, v), ctrl, rmask, 0xf, false))
    DPP_ADD(0x111, 0xf); DPP_ADD(0x112, 0xf); DPP_ADD(0x114, 0xf); DPP_ADD(0x118, 0xf); DPP_ADD(0x142, 0xa); DPP_ADD(0x143, 0xc);
#undef DPP_ADD
    return v;
}
__device__ __forceinline__ bf16x8 cat44(bf16x4 a, bf16x4 b) { return (bf16x8){a[0], a[1], a[2], a[3], b[0], b[1], b[2], b[3]}; }
__device__ __forceinline__ unsigned pk2f(float lo, float hi) { typedef __bf16 b2 __attribute__((ext_vector_type(2))); typedef float f2 __attribute__((ext_vector_type(2))); return __builtin_bit_cast(unsigned, __builtin_convertvector((f2){lo, hi}, b2)); }
__device__ __forceinline__ void gla_fast(Frame& F) {
    const int tid = F.tid, lane = F.lane, w = F.wave, vt = w >> 1, tt = w & 1, ql = lane & 31, hh = lane >> 5;
    LAS bf16* qin = (LAS bf16*)(F.lds + G_QIN); LAS bf16* kin = (LAS bf16*)(F.lds + G_KIN); LAS bf16* kinT = (LAS bf16*)(F.lds + G_KINT); LAS bf16* vT = (LAS bf16*)(F.lds + G_VT);
    LAS bf16* ST = (LAS bf16*)(F.lds + G_ST); LAS float* Wg = (LAS float*)(F.lds + G_WG); LAS float* bg = (LAS float*)(F.lds + G_BG); LAS float* ebl = (LAS float*)(F.lds + G_EBL); LAS float* pp = (LAS float*)(F.lds + G_PP);
    constexpr float LOG2E = 1.44269504f, LN2 = 0.69314718f;
    for (int unit = blockIdx.x; unit < BATCH * 4; unit += F.G) {
        const int b = unit >> 2, h = unit & 3;
        __syncthreads();
        for (int e = tid; e < 1024; e += NWAVES * 64) Wg[e] = F.w_gate_up[(e >> 6) * 256 + h * 64 + (e & 63)];
        if (tid < 64) bg[tid] = F.b_gate[h * 64 + tid];
        for (int e = tid; e < 128 * GS; e += NWAVES * 64) ST[e] = 0;
        f32x16 sacc;
#pragma unroll
        for (int i = 0; i < 16; ++i) sacc[i] = 0.f;
        f32x4 gain[4];
#pragma unroll
        for (int g = 0; g < 4; ++g) gain[g] = *(const f32x4*)(F.gla_norm + h * 128 + 32 * vt + 8 * g + 4 * hh);
        const bf16* prow = F.P2 + ((size_t)b * SEQ + lane) * NP2;
        v4u g0 = *(const v4u*)(prow + C_GD), g1 = *(const v4u*)(prow + C_GD + 8);
        v4u qv = *(const v4u*)(prow + C_QB + h * 64 + 8 * w), kv = *(const v4u*)(prow + C_KB + h * 64 + 8 * w);
        v4u v0 = *(const v4u*)(prow + C_VB + h * 128 + 16 * w), v1 = *(const v4u*)(prow + C_VB + h * 128 + 16 * w + 8);
        __syncthreads();
        for (int n = 0; n < NCHUNK; ++n) {
            const size_t tok0 = (size_t)b * SEQ + n * CHUNK;
            LAS bf16* STc = ST + (n & 1) * 128 * GS; LAS bf16* STn = ST + ((n + 1) & 1) * 128 * GS; LAS float* ppc = pp + (n & 1) * 256;
            const int tl = 32 * tt + ql;
            const bf16* og = F.P2 + (tok0 + tl) * NP2 + C_OG + h * 128 + 32 * vt + 4 * hh;
            v2u ogw[4];
#pragma unroll
            for (int g = 0; g < 4; ++g) ogw[g] = *(const v2u*)(og + 8 * g);
            {
                float gdv[16];
                gdv[0] = bflo(g0.x); gdv[1] = bfhi(g0.x); gdv[2] = bflo(g0.y); gdv[3] = bfhi(g0.y); gdv[4] = bflo(g0.z); gdv[5] = bfhi(g0.z); gdv[6] = bflo(g0.w); gdv[7] = bfhi(g0.w);
                gdv[8] = bflo(g1.x); gdv[9] = bfhi(g1.x); gdv[10] = bflo(g1.y); gdv[11] = bfhi(g1.y); gdv[12] = bflo(g1.z); gdv[13] = bfhi(g1.z); gdv[14] = bflo(g1.w); gdv[15] = bfhi(g1.w);
                float xg[8];
                { const f32x4 ba = *(const LAS f32x4*)(bg + 8 * w), bb = *(const LAS f32x4*)(bg + 8 * w + 4);
                  xg[0] = ba[0]; xg[1] = ba[1]; xg[2] = ba[2]; xg[3] = ba[3]; xg[4] = bb[0]; xg[5] = bb[1]; xg[6] = bb[2]; xg[7] = bb[3]; }
#pragma unroll 2
                for (int r = 0; r < 16; ++r) { const f32x4 wa = *(const LAS f32x4*)(Wg + r * 64 + 8 * w), wb = *(const LAS f32x4*)(Wg + r * 64 + 8 * w + 4);
                    xg[0] += gdv[r] * wa[0]; xg[1] += gdv[r] * wa[1]; xg[2] += gdv[r] * wa[2]; xg[3] += gdv[r] * wa[3]; xg[4] += gdv[r] * wb[0]; xg[5] += gdv[r] * wb[1]; xg[6] += gdv[r] * wb[2]; xg[7] += gdv[r] * wb[3]; }
                const unsigned qw[4] = {qv.x, qv.y, qv.z, qv.w}, kw[4] = {kv.x, kv.y, kv.z, kv.w};
                float qo[8], ko[8];
#pragma unroll
                for (int i = 0; i < 8; ++i) {
                    const float la = (fminf(xg[i], 0.f) - LN2 * __builtin_amdgcn_logf(1.0f + __builtin_amdgcn_exp2f(-LOG2E * fabsf(xg[i])))) * (1.0f / 16.0f);
                    const float bc = wave_incl_scan(la);
                    const float eb = __builtin_amdgcn_exp2f(bc * LOG2E), enb = __builtin_amdgcn_rcpf(eb);
                    const float qq_ = (i & 1) ? bfhi(qw[i >> 1]) : bflo(qw[i >> 1]), kk_ = (i & 1) ? bfhi(kw[i >> 1]) : bflo(kw[i >> 1]);
                    qo[i] = qq_ * 0.125f * eb; ko[i] = kk_ * enb;
                    if (lane == 63) ebl[8 * w + i] = eb;
                }
                v4u qp, kp;
                qp.x = pk2f(qo[0], qo[1]); qp.y = pk2f(qo[2], qo[3]); qp.z = pk2f(qo[4], qo[5]); qp.w = pk2f(qo[6], qo[7]);
                kp.x = pk2f(ko[0], ko[1]); kp.y = pk2f(ko[2], ko[3]); kp.z = pk2f(ko[4], ko[5]); kp.w = pk2f(ko[6], ko[7]);
                *(LAS v4u*)(qin + lane * GS + 8 * w) = qp;
                *(LAS v4u*)(kin + lane * GS + 8 * w) = kp;
                const unsigned kpw[4] = {kp.x, kp.y, kp.z, kp.w};
#pragma unroll
                for (int e = 0; e < 4; ++e) { kinT[(8 * w + 2 * e) * GS + lane] = (bf16)(kpw[e] & 0xffffu); kinT[(8 * w + 2 * e + 1) * GS + lane] = (bf16)(kpw[e] >> 16); }
                const unsigned vw[8] = {v0.x, v0.y, v0.z, v0.w, v1.x, v1.y, v1.z, v1.w};
#pragma unroll
                for (int e = 0; e < 8; ++e) { vT[(16 * w + 2 * e) * GS + lane] = (bf16)(vw[e] & 0xffffu); vT[(16 * w + 2 * e + 1) * GS + lane] = (bf16)(vw[e] >> 16); }
            }
            __syncthreads();
            if (n + 1 < NCHUNK) { const bf16* pn = prow + (size_t)(n + 1) * CHUNK * NP2;
                g0 = *(const v4u*)(pn + C_GD); g1 = *(const v4u*)(pn + C_GD + 8);
                qv = *(const v4u*)(pn + C_QB + h * 64 + 8 * w); kv = *(const v4u*)(pn + C_KB + h * 64 + 8 * w);
                v0 = *(const v4u*)(pn + C_VB + h * 128 + 16 * w); v1 = *(const v4u*)(pn + C_VB + h * 128 + 16 * w + 8); }
            f32x16 acc;
#pragma unroll
            for (int i = 0; i < 16; ++i) acc[i] = 0.f;
            bf16x8 qB[4];
#pragma unroll
            for (int ks = 0; ks < 4; ++ks) qB[ks] = *(const LAS bf16x8*)(qin + (32 * tt + ql) * GS + 16 * ks + 8 * hh);
#pragma unroll
            for (int ks = 0; ks < 4; ++ks) { const bf16x8 sA = *(const LAS bf16x8*)(STc + (32 * vt + ql) * GS + 16 * ks + 8 * hh); acc = __builtin_amdgcn_mfma_f32_32x32x16_bf16(sA, qB[ks], acc, 0, 0, 0); }
            bf16x8 vA[2][2];
#pragma unroll
            for (int st = 0; st < 2; ++st)
#pragma unroll
                for (int s2 = 0; s2 < 2; ++s2) { const LAS bf16* vp = vT + (32 * vt + ql) * GS + 32 * st + 16 * s2 + 4 * hh; vA[st][s2] = cat44(*(const LAS bf16x4*)vp, *(const LAS bf16x4*)(vp + 8)); }
#pragma unroll
            for (int st = 0; st < 2; ++st) if (st <= tt) {
                f32x16 X;
#pragma unroll
                for (int i = 0; i < 16; ++i) X[i] = 0.f;
#pragma unroll
                for (int ks = 0; ks < 4; ++ks) { const bf16x8 kA = *(const LAS bf16x8*)(kin + (32 * st + ql) * GS + 16 * ks + 8 * hh); X = __builtin_amdgcn_mfma_f32_32x32x16_bf16(kA, qB[ks], X, 0, 0, 0); }
                if (st == tt) {
#pragma unroll
                    for (int i = 0; i < 16; ++i) { const int sl = (i & 3) + 8 * (i >> 2) + 4 * hh; X[i] = (sl > ql) ? 0.f : X[i]; }
                }
#pragma unroll
                for (int s2 = 0; s2 < 2; ++s2) {
                    const bf16x8 pf = pack8(X[8 * s2], X[8 * s2 + 1], X[8 * s2 + 2], X[8 * s2 + 3], X[8 * s2 + 4], X[8 * s2 + 5], X[8 * s2 + 6], X[8 * s2 + 7]);
                    acc = __builtin_amdgcn_mfma_f32_32x32x16_bf16(vA[st][s2], pf, acc, 0, 0, 0);
                }
            }
#pragma unroll
            for (int st = 0; st < 2; ++st)
#pragma unroll
                for (int s2 = 0; s2 < 2; ++s2) { const LAS bf16* kp2 = kinT + (32 * tt + ql) * GS + 32 * st + 16 * s2 + 4 * hh; const bf16x8 kB = cat44(*(const LAS bf16x4*)kp2, *(const LAS bf16x4*)(kp2 + 8));
                    sacc = __builtin_amdgcn_mfma_f32_32x32x16_bf16(vA[st][s2], kB, sacc, 0, 0, 0); }
            { const float eb = ebl[32 * tt + ql];
#pragma unroll
              for (int i = 0; i < 16; ++i) sacc[i] *= eb;
              LAS bf16* stp = STn + (32 * vt + 4 * hh) * GS + 32 * tt + ql;
#pragma unroll
              for (int i = 0; i < 16; i += 2) { const unsigned pw = pk2f(sacc[i], sacc[i + 1]);
                  stp[((i & 3) + 8 * (i >> 2)) * GS] = (bf16)(pw & 0xffffu); stp[((i & 3) + 1 + 8 * (i >> 2)) * GS] = (bf16)(pw >> 16); } }
            float ss = 0.f;
#pragma unroll
            for (int i = 0; i < 16; ++i) ss += acc[i] * acc[i];
            ss += __shfl_xor(ss, 32);
            if (hh == 0) ppc[vt * 64 + tl] = ss;
            __syncthreads();
            { const float tot = (ppc[tl] + ppc[64 + tl]) + (ppc[128 + tl] + ppc[192 + tl]);
              const float rr = __builtin_amdgcn_rsqf(tot * (1.0f / 128.0f) + EPS);
              bf16* orow = F.MIX + (tok0 + tl) * D + 512 + h * 128 + 32 * vt + 4 * hh;
#pragma unroll
              for (int g = 0; g < 4; ++g) { const float z0 = bflo(ogw[g].x), z1 = bfhi(ogw[g].x), z2 = bflo(ogw[g].y), z3 = bfhi(ogw[g].y);
                  const float y0 = acc[4 * g] * rr * gain[g][0] * z0 * __builtin_amdgcn_rcpf(1.0f + __builtin_amdgcn_exp2f(-LOG2E * z0));
                  const float y1 = acc[4 * g + 1] * rr * gain[g][1] * z1 * __builtin_amdgcn_rcpf(1.0f + __builtin_amdgcn_exp2f(-LOG2E * z1));
                  const float y2 = acc[4 * g + 2] * rr * gain[g][2] * z2 * __builtin_amdgcn_rcpf(1.0f + __builtin_amdgcn_exp2f(-LOG2E * z2));
                  const float y3 = acc[4 * g + 3] * rr * gain[g][3] * z3 * __builtin_amdgcn_rcpf(1.0f + __builtin_amdgcn_exp2f(-LOG2E * z3));
                  v2u ow; ow.x = pk2f(y0, y1); ow.y = pk2f(y2, y3); *(v2u*)(orow + 8 * g) = ow; } }
        }
    }
}

__device__ __forceinline__ void gla_simple(Frame& F) {
    LAS float* qin = (LAS float*)(F.lds + RING_OFF);
    LAS float* kin = qin + 64 * 65;
    LAS float* att = kin + 64 * 65;
    LAS float* vv = att + 64 * 65;
    LAS float* S = vv + 64 * 128;
    LAS float* gd = S + 64 * 128;
    LAS float* Wg = gd + 64 * 16;
    LAS float* bg = Wg + 16 * 64;
    LAS float* ebl = bg + 64;
    const int tid = F.tid, lane = F.lane, wave = F.wave;
    for (int unit = blockIdx.x; unit < BATCH * 4; unit += F.G) {
        const int b = unit >> 2, h = unit & 3;
        for (int e = tid; e < 1024; e += 512) Wg[e] = F.w_gate_up[(e >> 6) * 256 + h * 64 + (e & 63)];
        if (tid < 64) bg[tid] = F.b_gate[h * 64 + tid];
        for (int e = tid; e < 8192; e += 512) S[e] = 0.f;
        __syncthreads();
        for (int n = 0; n < NCHUNK; ++n) {
            const size_t tok0 = (size_t)b * SEQ + n * CHUNK;
            for (int e = tid; e < 1024; e += 512) gd[e] = bf2f(F.P2[(tok0 + (e >> 4)) * NP2 + C_GD + (e & 15)]);
            __syncthreads();
            for (int e = tid; e < 4096; e += 512) { const int t = e >> 6, d = e & 63; float xg = bg[d];
#pragma unroll
                for (int r = 0; r < 16; ++r) xg += gd[t * 16 + r] * Wg[r * 64 + d];
                att[t * 65 + d] = (fminf(xg, 0.f) - log1pf(__expf(-fabsf(xg)))) * (1.0f / 16.0f); }
            __syncthreads();
            if (tid < 64) { float run = 0.f; for (int t = 0; t < 64; ++t) { run += att[t * 65 + tid]; att[t * 65 + tid] = run; } ebl[tid] = __expf(run); }
            __syncthreads();
            for (int e = tid; e < 4096; e += 512) { const int t = e >> 6, d = e & 63; const float bc = att[t * 65 + d];
                const float q = bf2f(F.P2[(tok0 + t) * NP2 + C_QB + h * 64 + d]), k = bf2f(F.P2[(tok0 + t) * NP2 + C_KB + h * 64 + d]);
                qin[t * 65 + d] = q * 0.125f * __expf(bc); kin[t * 65 + d] = k * __expf(-bc); }
            for (int e = tid; e < 8192; e += 512) vv[e] = bf2f(F.P2[(tok0 + (e >> 7)) * NP2 + C_VB + h * 128 + (e & 127)]);
            __syncthreads();
            for (int e = tid; e < 4096; e += 512) { const int t = e >> 6, s = e & 63; float a = 0.f;
                if (s <= t) {
#pragma unroll 8
                    for (int d = 0; d < 64; ++d) a += qin[t * 65 + d] * kin[s * 65 + d]; }
                att[t * 65 + s] = a; }
            __syncthreads();
            const int v = tid & 127, q4 = tid >> 7; float o[16];
#pragma unroll
            for (int i = 0; i < 16; ++i) { const int t = q4 * 16 + i; float a = 0.f;
                for (int s = 0; s <= t; ++s) a += att[t * 65 + s] * vv[s * 128 + v];
#pragma unroll 8
                for (int d = 0; d < 64; ++d) a += qin[t * 65 + d] * S[d * 128 + v];
                o[i] = a; }
            __syncthreads();
#pragma unroll 1
            for (int i = 0; i < 16; ++i) { const int d = q4 * 16 + i; float a = 0.f;
#pragma unroll 8
                for (int s = 0; s < 64; ++s) a += kin[s * 65 + d] * vv[s * 128 + v];
                S[d * 128 + v] = ebl[d] * (S[d * 128 + v] + a); }
            __syncthreads();
#pragma unroll
            for (int i = 0; i < 16; ++i) vv[(q4 * 16 + i) * 128 + v] = o[i];
            __syncthreads();
            for (int r = 0; r < 8; ++r) { const int t = wave * 8 + r; const float x0 = vv[t * 128 + lane], x1 = vv[t * 128 + 64 + lane];
                const float rr = 1.0f / sqrtf(wave_sum(x0 * x0 + x1 * x1) * (1.0f / 128.0f) + EPS);
                const float g0 = bf2f(F.P2[(tok0 + t) * NP2 + C_OG + h * 128 + lane]), g1 = bf2f(F.P2[(tok0 + t) * NP2 + C_OG + h * 128 + 64 + lane]);
                const float y0 = x0 * rr * F.gla_norm[h * 128 + lane] * (g0 / (1.0f + __expf(-g0))), y1 = x1 * rr * F.gla_norm[h * 128 + 64 + lane] * (g1 / (1.0f + __expf(-g1)));
                F.MIX[(tok0 + t) * D + 512 + h * 128 + lane] = (bf16)f2bf(y0); F.MIX[(tok0 + t) * D + 512 + h * 128 + 64 + lane] = (bf16)f2bf(y1); }
            __syncthreads();
        }
    }
}

__device__ __forceinline__ void p6_final(Frame& F) {
    const int gw = blockIdx.x * NWAVES + F.wave, NGW = F.G * NWAVES, lane = F.lane;
    for (int m = gw; m < M; m += NGW) {
        const f32x4* rp = (const f32x4*)(F.RS2 + (size_t)m * 16); const f32x4 p0 = rp[0], p1 = rp[1], p2 = rp[2], p3 = rp[3];
        const float ssq = ((p0[0] + p0[1]) + (p0[2] + p0[3])) + ((p1[0] + p1[1]) + (p1[2] + p1[3])) + ((p2[0] + p2[1]) + (p2[2] + p2[3])) + ((p3[0] + p3[1]) + (p3[2] + p3[3]));
        const float r = 1.0f / sqrtf(ssq * (1.0f / D) + EPS);
        f32x4* xr = (f32x4*)(F.out + (size_t)m * D) + lane; const f32x4* gr = (const f32x4*)F.norm_final + lane;
#pragma unroll
        for (int j = 0; j < 4; ++j) { const f32x4 v = xr[64 * j], g = gr[64 * j]; xr[64 * j] = v * r * g; }
    }
}

struct Args { const float* in[13]; float* out; unsigned char* ws; int ph_lo, ph_hi; };
__global__ void __launch_bounds__(NWAVES * 64, 2) fwd(Args args) {
    extern __shared__ __attribute__((aligned(16))) unsigned char lds[];
    Frame F;
    F.lds = (LAS unsigned char*)lds;
    F.MISC = (volatile LAS unsigned*)(F.lds + MISC_OFF);
    F.tid = threadIdx.x; F.lane = F.tid & 63; F.wave = __builtin_amdgcn_readfirstlane(F.tid >> 6);
    F.G = gridDim.x;
    unsigned char* ws = args.ws;
    F.ctl = (unsigned*)(ws + WS_CTL);
    F.x = args.in[0]; F.norm_mix = args.in[1]; F.w_in = args.in[2]; F.w_gate_up = args.in[3]; F.b_gate = args.in[4]; F.gla_norm = args.in[5]; F.w_out = args.in[6]; F.rel_bias = args.in[7];
    F.norm_ffn = args.in[8]; F.w_ffn_gate = args.in[9]; F.w_ffn_up = args.in[10]; F.w_ffn_down = args.in[11]; F.norm_final = args.in[12]; F.out = args.out;
    F.WIN = (bf16*)(ws + WS_WIN); F.WOUT = (bf16*)(ws + WS_WOUT); F.WGU = (bf16*)(ws + WS_WGU); F.WDN = (bf16*)(ws + WS_WDN);
    F.H = (bf16*)(ws + WS_H); F.QT = (bf16*)(ws + WS_QT); F.KT = (bf16*)(ws + WS_KT); F.VT = (bf16*)(ws + WS_VT); F.P2 = (bf16*)(ws + WS_P2); F.MIX = (bf16*)(ws + WS_MIX); F.ACT = (bf16*)(ws + WS_ACT);
    F.RS1 = (float*)(ws + WS_RS1); F.RS2 = (float*)(ws + WS_RS2);
    for (int u = F.tid; u < (LDS_BYTES - LDSCTL_OFF) / 4; u += NWAVES * 64) ((LAS unsigned*)(F.lds + LDSCTL_OFF))[u] = 0u;
    __syncthreads();
    XcdBarrier bar; bar.bar = F.ctl + CW_BAR; bar.x = 0; bar.st = nullptr;
    if (N_LAUNCHES == 1) bar = xcd_barrier_post(F.ctl + CW_BAR, F.MISC + 8);
    const int lo = args.ph_lo, hi = args.ph_hi;
#define IN(k) (lo <= (k) && (k) < hi)
#define SEAM(k) do { if (IN(k) && IN((k) + 1)) xcd_barrier(bar); } while (0)
#ifndef PROBE_PHASE
#define PROBE_PHASE -1
#endif
#define PH1() do { \
        { pg8::Gemm g{F.H, F.WIN, M, 3072, D}; pg8::StaticOrder S; S.init(M, 3072, F.G, (int)blockIdx.x); \
          pg8::EpiProjA E{F.QT, F.KT, F.P2}; \
          pg8::gemm_phase<pg8::EpiProjA, pg8::StaticOrder, true, true, false>(F.lds + RING_OFF, g, S, E); } \
        { pg8::Gemm g{F.H, F.WIN + (size_t)3072 * D, M, 512, D}; pg8::StaticOrder S; S.init(M, 512, F.G, (int)blockIdx.x); \
          pg8::EpiVT E{F.VT}; \
          pg8::gemm_phase<pg8::EpiVT, pg8::StaticOrder, true, true, true>(F.lds + RING_OFF, g, S, E); } } while (0)
#define PH2(rep) do { gla_fast(F); __syncthreads(); dsa_fast(F, CW_QUEUE + 1024 * (rep)); } while (0)
#define PH3() do { pg8::Gemm g{F.MIX, F.WOUT, M, D, D}; pg8::StaticOrder S; S.init(M, D, F.G, (int)blockIdx.x); \
        pg8::EpiOut E{F.x, F.out, F.H, F.norm_ffn, F.RS1}; \
        pg8::gemm_phase<pg8::EpiOut, pg8::StaticOrder, true, true>(F.lds + RING_OFF, g, S, E); } while (0)
#define PH4() do { pg8::Gemm g{F.H, F.WGU, M, NGU, D}; pg8::StaticOrder S; S.init(M, NGU, F.G, (int)blockIdx.x); \
        pg8::EpiGU E{F.RS1, F.ACT, EPS}; \
        pg8::gemm_phase<pg8::EpiGU, pg8::StaticOrder, true, true>(F.lds + RING_OFF, g, S, E); } while (0)
#define PROBE(k, call) do { if (PROBE_PHASE == (k)) { xcd_barrier(bar); call; } } while (0)

    if (IN(0)) { p0_prologue(F); PROBE(0, p0_prologue(F)); }
    SEAM(0);
    if (IN(1)) { PH1(); PROBE(1, PH1()); }
    SEAM(1);
    if (IN(2)) { PH2(0); PROBE(2, PH2(1)); PROBE(20, gla_fast(F)); PROBE(21, dsa_fast(F, CW_QUEUE + 1024)); PROBE(22, dsa_fast<true>(F, CW_QUEUE + 1024)); PROBE(27, (dsa_fast<false, 99>(F, CW_QUEUE + 1024))); PROBE(23, (dsa_fast<true, 1>(F, CW_QUEUE + 1024))); PROBE(24, (dsa_fast<true, 2>(F, CW_QUEUE + 1024))); PROBE(25, (dsa_fast<true, 14>(F, CW_QUEUE + 1024))); PROBE(26, (dsa_fast<true, 18>(F, CW_QUEUE + 1024))); }
    SEAM(2);
    if (IN(3)) { PH3(); PROBE(3, PH3()); }
    SEAM(3);
    if (IN(4)) { PH4(); PROBE(4, PH4()); }
    SEAM(4);
    if (IN(5)) {
        pg8::Gemm g{F.ACT, F.WDN, M, D, FF}; pg8::StaticOrder S; S.init(M, D, F.G, (int)blockIdx.x);
        pg8::EpiDown E{F.out, F.RS2};
        pg8::gemm_phase<pg8::EpiDown, pg8::StaticOrder, true, true>(F.lds + RING_OFF, g, S, E);
    }
    SEAM(5);
    if (IN(6)) { p6_final(F); }
#undef IN
#undef SEAM
}

extern "C" void kernel_launch(void* const* d_in, const int* in_sizes, int n_in, void* d_out, int out_size, void* d_ws, size_t ws_size, hipStream_t stream) {
    static int grid = 0;
    if (grid == 0) {
        if (n_in != 13 || in_sizes[0] != M * D || out_size != M * D || ws_size < WS_END) { fprintf(stderr, "kernel_launch: unexpected shapes (n_in %d, in0 %d, out %d, ws %zu)\n", n_in, n_in > 0 ? in_sizes[0] : -1, out_size, ws_size); grid = -1; return; }
        int dev = 0, cus = 0, per_cu = 0;
        if (hipGetDevice(&dev) != hipSuccess || hipDeviceGetAttribute(&cus, hipDeviceAttributeMultiprocessorCount, dev) != hipSuccess) { grid = -1; return; }
        if (hipFuncSetAttribute((const void*)fwd, hipFuncAttributeMaxDynamicSharedMemorySize, LDS_BYTES) != hipSuccess) { fprintf(stderr, "kernel_launch: hipFuncSetAttribute failed\n"); grid = -1; return; }
        if (hipOccupancyMaxActiveBlocksPerMultiprocessor(&per_cu, (const void*)fwd, NWAVES * 64, LDS_BYTES) != hipSuccess || per_cu < 1) fprintf(stderr, "kernel_launch: occupancy query reports %d\n", per_cu);
        (void)hipGetLastError();
        grid = cus;
    }
    if (grid < 0) return;
    (void)hipMemsetAsync((char*)d_ws + WS_CTL, 0, CTL_ZERO_BYTES, stream);
    Args a{};
    for (int i = 0; i < 13; ++i) a.in[i] = (const float*)d_in[i];
    a.out = (float*)d_out; a.ws = (unsigned char*)d_ws;
    if (N_LAUNCHES == 1) { a.ph_lo = 0; a.ph_hi = N_PHASES; hipLaunchKernelGGL(fwd, dim3(grid), dim3(NWAVES * 64), LDS_BYTES, stream, a); }
    else for (int p = 0; p < N_PHASES; ++p) { a.ph_lo = p; a.ph_hi = p + 1; hipLaunchKernelGGL(fwd, dim3(grid), dim3(NWAVES * 64), LDS_BYTES, stream, a); }
}
```
